# Optimizing an MI355X kernel written in HIP

```python
import math
import jax, jax.numpy as jnp
from jax import lax
import numpy as np

D_MODEL = 1024
BATCH = 4
SEQ = 8192
DEPTH = 1

ROPE_THETA = 500000.0
EPS = 1e-6
Q_BLOCK = 128
D_FF = 2816

MLA_HEADS = 8
MLA_Q_RANK = 256
MLA_KV_RANK = 128
MLA_NOPE = 64
MLA_ROPE = 32
MLA_V = 64
MLA_WIDTH = MLA_HEADS * MLA_V

DIFF_HEADS = 4
DIFF_HEAD_DIM = 64
DIFF_ROT = DIFF_HEAD_DIM // 4
DIFF_WIDTH = DIFF_HEADS * 2 * DIFF_HEAD_DIM

IN_SPLITS = (MLA_Q_RANK, MLA_KV_RANK, MLA_ROPE, DIFF_WIDTH, DIFF_WIDTH, DIFF_WIDTH, D_MODEL, D_MODEL)
IN_COLS = sum(IN_SPLITS)

kernel_name = "hybrid_mla_diffattn_gated_macaron"


def rms_norm(x, w):
    xf = x.astype(jnp.float32)
    y = xf * lax.rsqrt(jnp.mean(xf * xf, axis=-1, keepdims=True) + EPS)
    return (y * w.astype(jnp.float32)).astype(x.dtype)


def swiglu(x, w_gate, w_up, w_down):
    return (jax.nn.silu(x @ w_gate) * (x @ w_up)) @ w_down


def apply_rope(x, positions, rot_dim):
    half = rot_dim // 2
    inv_freq = jnp.power(jnp.float32(ROPE_THETA), -2.0 * jnp.arange(half, dtype=jnp.float32) / rot_dim)
    ang = positions.astype(jnp.float32)[..., None] * inv_freq
    cos = jnp.cos(ang)[:, :, None, :]
    sin = jnp.sin(ang)[:, :, None, :]
    xr = x[..., :rot_dim].astype(jnp.float32)
    x1, x2 = xr[..., :half], xr[..., half:]
    rot = jnp.concatenate([x1 * cos - x2 * sin, x2 * cos + x1 * sin], axis=-1).astype(x.dtype)
    return jnp.concatenate([rot, x[..., rot_dim:]], axis=-1)


def to_blocks(t):
    b, s, h, d = t.shape
    return t.reshape(b, s // Q_BLOCK, Q_BLOCK, h, d).transpose(1, 0, 3, 2, 4)


def from_blocks(t):
    nb, b, h, qb, d = t.shape
    return t.transpose(1, 0, 3, 2, 4).reshape(b, nb * qb, h, d)


def causal_probs(q_blk, k, blk_idx, scale):
    s = jnp.einsum('bhqd,bhkd->bhqk', q_blk, k).astype(jnp.float32) * scale
    q_pos = blk_idx * Q_BLOCK + jnp.arange(Q_BLOCK)
    k_pos = jnp.arange(k.shape[2])
    mask = k_pos[None, :] <= q_pos[:, None]
    s = jnp.where(mask, s, -jnp.inf)
    return jax.nn.softmax(s, axis=-1)


def mla_branch(c_q, c_kv, k_rope_raw, positions, q_norm, w_uq, kv_norm, w_ukv):
    b, s, _ = c_q.shape
    q = (rms_norm(c_q, q_norm) @ w_uq).reshape(b, s, MLA_HEADS, MLA_NOPE + MLA_ROPE)
    q = jnp.concatenate([q[..., :MLA_NOPE], apply_rope(q[..., MLA_NOPE:], positions, MLA_ROPE)], axis=-1)
    kv = (rms_norm(c_kv, kv_norm) @ w_ukv).reshape(b, s, MLA_HEADS, MLA_NOPE + MLA_V)
    k_nope, v = kv[..., :MLA_NOPE], kv[..., MLA_NOPE:]
    k_rope = apply_rope(k_rope_raw.reshape(b, s, 1, MLA_ROPE), positions, MLA_ROPE)
    k = jnp.concatenate([k_nope, jnp.broadcast_to(k_rope, (b, s, MLA_HEADS, MLA_ROPE))], axis=-1)
    kt = k.transpose(0, 2, 1, 3)
    vt = v.transpose(0, 2, 1, 3)
    scale = (MLA_NOPE + MLA_ROPE) ** -0.5

    def block(args):
        qb, i = args
        p = causal_probs(qb, kt, i, scale)
        return jnp.einsum('bhqk,bhkd->bhqd', p.astype(vt.dtype), vt)

    out = lax.map(block, (to_blocks(q), jnp.arange(s // Q_BLOCK)))
    return from_blocks(out).reshape(b, s, MLA_WIDTH)


def diff_branch(q, k, v, positions, lam_q1, lam_k1, lam_q2, lam_k2, subln, layer_idx):
    b, s, _ = q.shape
    hd = DIFF_HEAD_DIM
    q = apply_rope(q.reshape(b, s, 2 * DIFF_HEADS, hd), positions, DIFF_ROT).reshape(b, s, DIFF_HEADS, 2, hd)
    k = apply_rope(k.reshape(b, s, 2 * DIFF_HEADS, hd), positions, DIFF_ROT).reshape(b, s, DIFF_HEADS, 2, hd)
    v = v.reshape(b, s, DIFF_HEADS, 2 * hd)
    q1, q2 = q[..., 0, :], q[..., 1, :]
    k1t = k[..., 0, :].transpose(0, 2, 1, 3)
    k2t = k[..., 1, :].transpose(0, 2, 1, 3)
    vt = v.transpose(0, 2, 1, 3)
    lam_init = 0.8 - 0.6 * math.exp(-0.3 * (layer_idx - 1))
    f32 = jnp.float32
    lam = (jnp.exp(jnp.sum(lam_q1.astype(f32) * lam_k1.astype(f32)))
           - jnp.exp(jnp.sum(lam_q2.astype(f32) * lam_k2.astype(f32))) + lam_init)
    scale = hd ** -0.5

    def block(args):
        q1b, q2b, i = args
        a = causal_probs(q1b, k1t, i, scale) - lam * causal_probs(q2b, k2t, i, scale)
        return jnp.einsum('bhqk,bhkd->bhqd', a.astype(vt.dtype), vt)

    out = from_blocks(lax.map(block, (to_blocks(q1), to_blocks(q2), jnp.arange(s // Q_BLOCK))))
    out = rms_norm(out, subln) * (1.0 - lam_init)
    return out.reshape(b, s, DIFF_WIDTH)


def hybrid_layer(x, positions, layer_idx,
                 ffn1_norm, ffn1_w_gate, ffn1_w_up, ffn1_w_down,
                 mix_norm, w_in,
                 mla_q_norm, mla_w_uq, mla_kv_norm, mla_w_ukv,
                 diff_lam_q1, diff_lam_k1, diff_lam_q2, diff_lam_k2, diff_subln,
                 w_proj_mla, w_proj_diff, w_out,
                 ffn2_norm, ffn2_w_gate, ffn2_w_up, ffn2_w_down):
    x = x + 0.5 * swiglu(rms_norm(x, ffn1_norm), ffn1_w_gate, ffn1_w_up, ffn1_w_down)

    h = rms_norm(x, mix_norm)
    z = h @ w_in
    cuts = []
    acc = 0
    for n in IN_SPLITS[:-1]:
        acc += n
        cuts.append(acc)
    c_q, c_kv, k_rope_raw, dq, dk, dv, gate_mla, gate_diff = jnp.split(z, cuts, axis=-1)

    y_mla = mla_branch(c_q, c_kv, k_rope_raw, positions, mla_q_norm, mla_w_uq, mla_kv_norm, mla_w_ukv)
    y_diff = diff_branch(dq, dk, dv, positions, diff_lam_q1, diff_lam_k1, diff_lam_q2, diff_lam_k2,
                         diff_subln, layer_idx)

    merged = (jax.nn.sigmoid(gate_mla) * (y_mla @ w_proj_mla)
              + jax.nn.sigmoid(gate_diff) * (y_diff @ w_proj_diff))
    x = x + merged @ w_out

    x = x + 0.5 * swiglu(rms_norm(x, ffn2_norm), ffn2_w_gate, ffn2_w_up, ffn2_w_down)
    return x


def setup_inputs(seed: int = 0) -> dict:
    key = jax.random.key(seed)
    ks = jax.random.split(key, 32)
    f32 = jnp.float32

    def w(k, fan_in, fan_out):
        return jax.random.normal(k, (DEPTH, fan_in, fan_out), f32) * fan_in ** -0.5

    def gain(k, n):
        return 1.0 + 0.01 * jax.random.normal(k, (DEPTH, n), f32)

    x = jax.random.normal(ks[0], (BATCH, SEQ, D_MODEL), f32)
    offsets = jax.random.randint(ks[1], (BATCH, 1), 0, 1024, dtype=jnp.int32)
    positions = jnp.arange(SEQ, dtype=jnp.int32)[None, :] + offsets
    return {
        "x": x,
        "positions": positions,
        "ffn1_norm": gain(ks[2], D_MODEL),
        "ffn1_w_gate": w(ks[3], D_MODEL, D_FF),
        "ffn1_w_up": w(ks[4], D_MODEL, D_FF),
        "ffn1_w_down": w(ks[5], D_FF, D_MODEL),
        "mix_norm": gain(ks[6], D_MODEL),
        "w_in": w(ks[7], D_MODEL, IN_COLS),
        "mla_q_norm": gain(ks[8], MLA_Q_RANK),
        "mla_w_uq": w(ks[9], MLA_Q_RANK, MLA_HEADS * (MLA_NOPE + MLA_ROPE)),
        "mla_kv_norm": gain(ks[10], MLA_KV_RANK),
        "mla_w_ukv": w(ks[11], MLA_KV_RANK, MLA_HEADS * (MLA_NOPE + MLA_V)),
        "diff_lam_q1": 0.1 * jax.random.normal(ks[12], (DEPTH, DIFF_HEAD_DIM), f32),
        "diff_lam_k1": 0.1 * jax.random.normal(ks[13], (DEPTH, DIFF_HEAD_DIM), f32),
        "diff_lam_q2": 0.1 * jax.random.normal(ks[14], (DEPTH, DIFF_HEAD_DIM), f32),
        "diff_lam_k2": 0.1 * jax.random.normal(ks[15], (DEPTH, DIFF_HEAD_DIM), f32),
        "diff_subln": gain(ks[16], 2 * DIFF_HEAD_DIM),
        "w_proj_mla": w(ks[17], MLA_WIDTH, D_MODEL),
        "w_proj_diff": w(ks[18], DIFF_WIDTH, D_MODEL),
        "w_out": w(ks[19], D_MODEL, D_MODEL),
        "ffn2_norm": gain(ks[20], D_MODEL),
        "ffn2_w_gate": w(ks[21], D_MODEL, D_FF),
        "ffn2_w_up": w(ks[22], D_MODEL, D_FF),
        "ffn2_w_down": w(ks[23], D_FF, D_MODEL),
        "final_norm": 1.0 + 0.01 * jax.random.normal(ks[24], (D_MODEL,), f32),
    }


def reference(x, positions,
              ffn1_norm, ffn1_w_gate, ffn1_w_up, ffn1_w_down,
              mix_norm, w_in,
              mla_q_norm, mla_w_uq, mla_kv_norm, mla_w_ukv,
              diff_lam_q1, diff_lam_k1, diff_lam_q2, diff_lam_k2, diff_subln,
              w_proj_mla, w_proj_diff, w_out,
              ffn2_norm, ffn2_w_gate, ffn2_w_up, ffn2_w_down,
              final_norm):
    for l in range(DEPTH):
        x = hybrid_layer(
            x, positions, l + 1,
            ffn1_norm[l], ffn1_w_gate[l], ffn1_w_up[l], ffn1_w_down[l],
            mix_norm[l], w_in[l],
            mla_q_norm[l], mla_w_uq[l], mla_kv_norm[l], mla_w_ukv[l],
            diff_lam_q1[l], diff_lam_k1[l], diff_lam_q2[l], diff_lam_k2[l], diff_subln[l],
            w_proj_mla[l], w_proj_diff[l], w_out[l],
            ffn2_norm[l], ffn2_w_gate[l], ffn2_w_up[l], ffn2_w_down[l])
    return rms_norm(x, final_norm)
```

```cpp
#include <hip/hip_runtime.h>
#include <hip/hip_cooperative_groups.h>
#include <cstdio>
#include <cstdint>
#include <cmath>
namespace cg = cooperative_groups;

namespace pg8 {
#define PG8_LAS __attribute__((address_space(3)))
typedef unsigned short bf16_t;
typedef short bf16x8 __attribute__((ext_vector_type(8)));
typedef float f32x4 __attribute__((ext_vector_type(4)));
typedef unsigned u32x4 __attribute__((ext_vector_type(4)));
constexpr int BM = 256, BK = 64, HALF = 128, HTB = HALF * BK * 2  , STAGE_BYTES = 8 * HTB, NXCD = 8, WGM = 8;

__host__ __device__ __forceinline__ int lds_byte(int r, int c) { const int st = (r >> 4) * 2 + (c >> 5), rr = r & 15, cc = c & 31, ob = rr * 64 + cc * 2; return st * 1024 + (ob ^ (((ob >> 9) & 1) << 5)); }
__host__ __device__ __forceinline__ void stage_rc(int b, int& R, int& C) { const int st = b / 1024, sb = b % 1024, swz = sb ^ (((sb >> 9) & 1) << 5); R = (st >> 1) * 16 + swz / 64; C = (st & 1) * 32 + (swz % 64) / 2; }
__host__ __device__ __forceinline__ int perm32(int rho) { const int n = rho >> 4, i = rho & 15; return 8 * (i >> 2) + 4 * n + (i & 3); }

struct Unit { int pm, pn; };
struct Gemm { const bf16_t* A; const bf16_t* Bt; int M, N, K; };

struct StaticOrder {
    int nM, nN, nwg, G, c;
    __host__ __device__ void init(int M, int N, int G_, int c_) { nM = M / BM; nN = N / BM; nwg = nM * nN; G = G_; c = c_; }
    __host__ __device__ bool next(int i, Unit& u) const {
        const long L = (long)i * G + c; if (L >= nwg) return false;
        int wgid = (int)L; { const int q = nwg / NXCD, r = nwg % NXCD, xcd = wgid % NXCD, off = wgid / NXCD; wgid = (xcd < r ? xcd * (q + 1) : r * (q + 1) + (xcd - r) * q) + off; }
        const int nig = WGM * nN, gid = wgid / nig, fm = gid * WGM, gsz = (nM - fm) < WGM ? (nM - fm) : WGM;
        u.pm = fm + ((wgid % nig) % gsz); u.pn = (wgid % nig) / gsz; return true;
    }
    __device__ __forceinline__ void a_ready(const Unit&) const {}
    __device__ __forceinline__ void done(const Unit&) const {}
};

__device__ __forceinline__ unsigned cvt_pk_bf16(float lo, float hi) { unsigned r; asm volatile("v_cvt_pk_bf16_f32 %0, %1, %2" : "=v"(r) : "v"(lo), "v"(hi)); return r; }
template <class Epi, class Sched, bool ALIGN_EPI = false, bool SP2 = false>
__device__ __forceinline__ void gemm_phase(PG8_LAS unsigned char* lds, const Gemm g, const Sched& S, const Epi& E) {
    int tid_l = threadIdx.x; asm volatile("" : "+v"(tid_l));
    const int tid = tid_l, wid = __builtin_amdgcn_readfirstlane(tid >> 6), lane = tid & 63, wr = wid >> 2, wc = wid & 3, fr = lane & 15, fq = lane >> 4;
    const int K = g.K, nt = K / BK;
    unsigned voffA[2], voffB[2];
#pragma unroll
    for (int i = 0; i < 2; ++i) { int R, C; stage_rc(tid * 16 + i * 8192, R, C); const int Rb = Epi::PERM ? ((R & ~31) + perm32(R & 31)) : R;
        voffA[i] = (unsigned)(R * K + C) * 2u; voffB[i] = (unsigned)(Rb * K + C) * 2u; }
    const size_t kstep = (size_t)(BK * 2);
    const size_t hstep = (size_t)HALF * K * 2;
    const size_t tstep = 2 * hstep;
    const unsigned ldsw = (unsigned)wid * 1024u;
    const int aoff = lds_byte(wr * 64 + fr, fq * 8), boff = lds_byte(wc * 32 + fr, fq * 8);
#define PG8_SA(b, h) (((b) * 2 + (h)) * HTB)
#define PG8_SB(b, h) ((4 + (b) * 2 + (h)) * HTB)
#define PG8_STAGE(bufoff, gbase, voff) do { _Pragma("unroll") for (int _i = 0; _i < 2; ++_i) \
        __builtin_amdgcn_global_load_lds((const unsigned*)((const char*)(gbase) + (voff)[_i]), (PG8_LAS unsigned*)(lds + (bufoff) + ldsw + _i * 8192), 16, 0, 0); } while (0)
#define PG8_LDA(dst, b, h) do { _Pragma("unroll") for (int m = 0; m < 4; ++m) _Pragma("unroll") for (int k = 0; k < 2; ++k) dst[m][k] = *(const PG8_LAS bf16x8*)(lds + PG8_SA(b, h) + aoff + m * 2048 + k * 1024); } while (0)
#define PG8_LDB(dst, b, h) do { _Pragma("unroll") for (int n = 0; n < 2; ++n) _Pragma("unroll") for (int k = 0; k < 2; ++k) dst[n][k] = *(const PG8_LAS bf16x8*)(lds + PG8_SB(b, h) + boff + n * 2048 + k * 1024); } while (0)
#define PG8_MMA(ai, bj, At, Bt) do { __builtin_amdgcn_s_setprio(1); _Pragma("unroll") for (int m = 0; m < 4; ++m) _Pragma("unroll") for (int n = 0; n < 2; ++n) _Pragma("unroll") for (int k = 0; k < 2; ++k) \
        acc[ai][bj][m][n] = __builtin_amdgcn_mfma_f32_16x16x32_bf16(Bt[n][k], At[m][k], acc[ai][bj][m][n], 0, 0, 0); __builtin_amdgcn_s_setprio(0); } while (0)
#define PG8_WAIT_V(n) asm volatile("s_waitcnt vmcnt(" #n ")" ::: "memory")
#define PG8_WAIT_L(n) asm volatile("s_waitcnt lgkmcnt(" #n ")" ::: "memory")
#define PG8_BAR __builtin_amdgcn_s_barrier()
#define PG8_SCHED __builtin_amdgcn_sched_barrier(0)
    Unit cur, nxt; int ui = 0;
    if (!S.next(0, cur)) return;
    f32x4 acc[2][2][4][2];
#pragma unroll
    for (int a = 0; a < 2; ++a)
#pragma unroll
        for (int b = 0; b < 2; ++b)
#pragma unroll
            for (int m = 0; m < 4; ++m)
#pragma unroll
                for (int n = 0; n < 2; ++n) acc[a][b][m][n] = (f32x4){0.f, 0.f, 0.f, 0.f};
    bf16x8 At[4][2], B0[2][2], B1[2][2];
    const char* cA = (const char*)g.A + (size_t)cur.pm * tstep; const char* cB = (const char*)g.Bt + (size_t)cur.pn * tstep;
    S.a_ready(cur);
    if constexpr (SP2) {
        PG8_STAGE(PG8_SB(0, 0), cB, voffB); PG8_STAGE(PG8_SB(0, 1), cB + hstep, voffB); PG8_STAGE(PG8_SA(0, 0), cA, voffA); PG8_STAGE(PG8_SA(0, 1), cA + hstep, voffA);
        if (wr == 1) PG8_BAR;
        PG8_WAIT_V(2); PG8_BAR;
        PG8_STAGE(PG8_SB(1, 0), cB + kstep, voffB); PG8_STAGE(PG8_SA(1, 0), cA + kstep, voffA); PG8_STAGE(PG8_SB(1, 1), cB + hstep + kstep, voffB);
        PG8_WAIT_V(6); PG8_BAR;
    } else {
        PG8_STAGE(PG8_SB(0, 0), cB, voffB); PG8_STAGE(PG8_SA(0, 0), cA, voffA); PG8_STAGE(PG8_SB(0, 1), cB + hstep, voffB); PG8_STAGE(PG8_SA(0, 1), cA + hstep, voffA);
        if (wr == 1) PG8_BAR;
        PG8_WAIT_V(4); PG8_BAR;
        PG8_STAGE(PG8_SB(1, 0), cB + kstep, voffB); PG8_STAGE(PG8_SA(1, 0), cA + kstep, voffA); PG8_STAGE(PG8_SB(1, 1), cB + hstep + kstep, voffB);
        PG8_WAIT_V(6); PG8_BAR;
    }
    for (;;) {
        const bool has_next = S.next(ui + 1, nxt);
        const char* nA = has_next ? (const char*)g.A + (size_t)nxt.pm * tstep : cA; const char* nB = has_next ? (const char*)g.Bt + (size_t)nxt.pn * tstep : cB;
        for (int t = 0; t < nt; t += 2) {
            if (E.mid_at == t) E.mid(acc, cur, wr, wc, fr, fq);
            const bool last = (t == nt - 2);
            const char* a1 = cA + (size_t)(t + 1) * kstep;
            const char* a2 = last ? nA : cA + (size_t)(t + 2) * kstep; const char* b2 = last ? nB : cB + (size_t)(t + 2) * kstep;
            const char* a3 = a2 + kstep; const char* b3 = b2 + kstep;
            if (last && has_next) S.a_ready(nxt);
            if constexpr (SP2) {
            PG8_LDB(B0, 0, 0); PG8_LDB(B1, 0, 1); PG8_SCHED; PG8_LDA(At, 0, 0); PG8_STAGE(PG8_SA(1, 1), a1 + hstep, voffA);
            PG8_WAIT_V(8); PG8_WAIT_L(0); PG8_BAR; PG8_MMA(0, 0, At, B0); PG8_MMA(0, 1, At, B1); PG8_BAR; PG8_SCHED;
            PG8_LDA(At, 0, 1); PG8_STAGE(PG8_SB(0, 0), b2, voffB); PG8_STAGE(PG8_SB(0, 1), b2 + hstep, voffB); PG8_STAGE(PG8_SA(0, 0), a2, voffA);
            PG8_WAIT_V(8); PG8_WAIT_L(0); PG8_BAR; PG8_MMA(1, 0, At, B0); PG8_MMA(1, 1, At, B1); PG8_BAR; PG8_SCHED;
            PG8_LDB(B0, 1, 0); PG8_LDB(B1, 1, 1); PG8_SCHED; PG8_LDA(At, 1, 0); PG8_STAGE(PG8_SA(0, 1), a2 + hstep, voffA);
            PG8_WAIT_V(8); PG8_WAIT_L(0); PG8_BAR; PG8_MMA(0, 0, At, B0); PG8_MMA(0, 1, At, B1); PG8_BAR; PG8_SCHED;
            PG8_LDA(At, 1, 1); PG8_STAGE(PG8_SB(1, 0), b3, voffB); PG8_STAGE(PG8_SB(1, 1), b3 + hstep, voffB); PG8_STAGE(PG8_SA(1, 0), a3, voffA);
            PG8_WAIT_V(8); PG8_WAIT_L(0); PG8_BAR; PG8_MMA(1, 0, At, B0); PG8_MMA(1, 1, At, B1); PG8_BAR; PG8_SCHED;
            } else {
            PG8_LDB(B0, 0, 0); PG8_SCHED; PG8_LDA(At, 0, 0); PG8_STAGE(PG8_SA(1, 1), a1 + hstep, voffA);
            PG8_WAIT_L(8); PG8_BAR; PG8_WAIT_L(0); PG8_MMA(0, 0, At, B0); PG8_BAR; PG8_SCHED;
            PG8_LDB(B1, 0, 1); PG8_STAGE(PG8_SB(0, 0), b2, voffB);
            PG8_BAR; PG8_WAIT_L(0); PG8_MMA(0, 1, At, B1); PG8_BAR;
            PG8_LDA(At, 0, 1); PG8_STAGE(PG8_SA(0, 0), a2, voffA);
            PG8_BAR; PG8_WAIT_L(0); PG8_MMA(1, 0, At, B0); PG8_BAR; PG8_SCHED;
            PG8_STAGE(PG8_SB(0, 1), b2 + hstep, voffB);
            PG8_WAIT_V(6); PG8_BAR; PG8_MMA(1, 1, At, B1); PG8_BAR;
            PG8_LDB(B0, 1, 0); PG8_SCHED; PG8_LDA(At, 1, 0); PG8_STAGE(PG8_SA(0, 1), a2 + hstep, voffA);
            PG8_WAIT_L(8); PG8_BAR; PG8_WAIT_L(0); PG8_MMA(0, 0, At, B0); PG8_BAR; PG8_SCHED;
            PG8_LDB(B1, 1, 1); PG8_STAGE(PG8_SB(1, 0), b3, voffB);
            PG8_BAR; PG8_WAIT_L(0); PG8_MMA(0, 1, At, B1); PG8_BAR;
            PG8_LDA(At, 1, 1); PG8_STAGE(PG8_SA(1, 0), a3, voffA);
            PG8_BAR; PG8_WAIT_L(0); PG8_MMA(1, 0, At, B0); PG8_BAR; PG8_SCHED;
            PG8_STAGE(PG8_SB(1, 1), b3 + hstep, voffB);
            PG8_WAIT_V(6); PG8_BAR; PG8_MMA(1, 1, At, B1); PG8_BAR;
            }
        }
        if constexpr (ALIGN_EPI) { if (wr == 0) PG8_BAR; }
        if constexpr (!Epi::AFTER_DRAIN) { E(acc, cur, wr, wc, fr, fq); S.done(cur); }
        if (!has_next) break;
#pragma unroll
        for (int a = 0; a < 2; ++a)
#pragma unroll
            for (int b = 0; b < 2; ++b)
#pragma unroll
                for (int m = 0; m < 4; ++m)
#pragma unroll
                    for (int n = 0; n < 2; ++n) acc[a][b][m][n] = (f32x4){0.f, 0.f, 0.f, 0.f};
        cur = nxt; cA = nA; cB = nB; ++ui;
        if constexpr (ALIGN_EPI) { if (wr == 1) PG8_BAR; }
    }
    PG8_WAIT_V(0);
    if constexpr (!ALIGN_EPI) { if (wr == 0) PG8_BAR; }
    PG8_BAR;
    if constexpr (Epi::AFTER_DRAIN) { E.fused(acc, cur, wr, wc, fr, fq, lds, wid, lane); S.done(cur); }
#undef PG8_SA
#undef PG8_SB
#undef PG8_STAGE
#undef PG8_LDA
#undef PG8_LDB
#undef PG8_MMA
#undef PG8_WAIT_V
#undef PG8_WAIT_L
#undef PG8_BAR
#undef PG8_SCHED
}
}

#define LAS __attribute__((address_space(3)))
typedef unsigned short bf16_t;
typedef float f32x4 __attribute__((ext_vector_type(4)));
typedef float f32x2 __attribute__((ext_vector_type(2)));
typedef float f32x16 __attribute__((ext_vector_type(16)));
typedef unsigned u32x4 __attribute__((ext_vector_type(4)));
typedef unsigned u32x2 __attribute__((ext_vector_type(2)));
typedef short bf16x8 __attribute__((ext_vector_type(8)));

constexpr int BATCH = 4, SEQ = 8192, T = BATCH * SEQ, DM = 1024, FF = 2816;
constexpr int NGU = 2 * FF;
constexpr int NWIN = 3584;
constexpr float EPS = 1e-6f;
constexpr int NUNITS = 32 * 48;
constexpr size_t MiB = 1u << 20;
constexpr size_t WS_CTL = 0, WS_BAR = 65536, BAR_BYTES = 16384;
constexpr size_t WS_SSQA = 1 * MiB, WS_SSQB = 3 * MiB, WS_SSQC = 5 * MiB, WS_SSQD = 7 * MiB, WS_SSQQ = 9 * MiB, WS_SSQKV = 9 * MiB + 512 * 1024;
constexpr size_t WS_TABM = 10 * MiB, WS_TABD = 14 * MiB;
constexpr size_t WS_W1GU = 16 * MiB, WS_W1D = 27 * MiB, WS_WIN = 33 * MiB, WS_WDV = 40 * MiB, WS_WUQ = 41 * MiB, WS_WUK = 41 * MiB + 512 * 1024, WS_WUV = 41 * MiB + 768 * 1024;
constexpr size_t WS_PM = 42 * MiB, WS_PD = 43 * MiB, WS_WO = 44 * MiB, WS_W2GU = 46 * MiB, WS_W2D = 57 * MiB;
constexpr size_t WS_XB = 64 * MiB, WS_YM = 64 * MiB, WS_YD = 96 * MiB;
constexpr size_t WS_H = 128 * MiB, WS_CQ = 128 * MiB, WS_CKV = 144 * MiB, WS_KN = 152 * MiB, WS_KR = 184 * MiB, WS_QM = 186 * MiB, WS_VTM = 234 * MiB, WS_VTD = 266 * MiB;
constexpr size_t WS_QD = 304 * MiB, WS_KD = 336 * MiB, WS_MG = 304 * MiB, WS_GM = 368 * MiB, WS_GD = 432 * MiB, WS_END = 496 * MiB;

constexpr int LDS_STAGE = 131072, LDS_BYTES = LDS_STAGE + 256;

struct KP {
    const float* x; const int* pos;
    const float *n1, *wg1, *wu1, *wd1, *nmix, *win, *nq, *wuq, *nkv, *wukv, *lq1, *lk1, *lq2, *lk2, *subln, *pm, *pd, *wo, *n2, *wg2, *wu2, *wd2, *nfin;
    float* out; unsigned char* ws;
    float invf_m[16]; float invf_d[8];
    float scale_m, scale_d, lam_init, one_m_lam;
};

typedef __bf16 bf16x2_t __attribute__((ext_vector_type(2)));
__device__ __forceinline__ unsigned cvtpk(float lo, float hi) { const f32x2 v = {lo, hi}; const bf16x2_t b = __builtin_convertvector(v, bf16x2_t); return __builtin_bit_cast(unsigned, b); }
__device__ __forceinline__ float bf_lo(unsigned w) { return __uint_as_float(w << 16); }
__device__ __forceinline__ float bf_hi(unsigned w) { return __uint_as_float(w & 0xffff0000u); }
__device__ __forceinline__ float wave_sum(float v) {
#pragma unroll
    for (int o = 1; o < 64; o <<= 1) v += __shfl_xor(v, o);
    return v;
}
__device__ __forceinline__ float sigmoidf_(float x) { return __builtin_amdgcn_rcpf(1.0f + __builtin_amdgcn_exp2f(-1.4426950408889634f * x)); }

#ifndef MODE_MASK
#define MODE_MASK 255
#endif
#define MEN(x) (((MODE_MASK) >> (x)) & 1)
enum { M_SWIGLU = 0, M_RESID = 1, M_WIN = 2, M_VT = 3, M_Q = 4, M_KN = 5, M_GATE1 = 6, M_GATE2 = 7 };
struct Epi {
    static constexpr bool PERM = true, AFTER_DRAIN = false;
    int mode, np; float inv_dim, f0;
    const float* ssq;
    const void* i0;
    void* o0; void* o1; float* ssq_out;
    unsigned char* ws; float scale; int mid_at;

    static __device__ __forceinline__ float rowsum(const float* ssq, int row, int np) {
        const f32x4* p = (const f32x4*)(ssq + (size_t)row * np);
        float s = 0.f;
        for (int i = 0; i < np / 4; ++i) { const f32x4 v = p[i]; s += (v[0] + v[1]) + (v[2] + v[3]); }
        return s;
    }
    __device__ __forceinline__ void row_scales(int rowbase, int lane, int fr, float (&rs)[2]) const {
        rs[0] = rsqrtf(rowsum(ssq, rowbase + lane, np) * inv_dim + EPS); rs[1] = rsqrtf(rowsum(ssq, rowbase + 128 + lane, np) * inv_dim + EPS);
    }
    static __device__ __forceinline__ u32x4 pack8(const f32x4 a, const f32x4 b) { u32x4 w; w.x = cvtpk(a[0], a[1]); w.y = cvtpk(a[2], a[3]); w.z = cvtpk(b[0], b[1]); w.w = cvtpk(b[2], b[3]); return w; }
    static __device__ __forceinline__ f32x4 rope4(const f32x4 v, const f32x4 cs) {
        f32x4 o; o[0] = v[0] * cs[0] - v[1] * cs[1]; o[1] = v[1] * cs[0] + v[0] * cs[1]; o[2] = v[2] * cs[2] - v[3] * cs[3]; o[3] = v[3] * cs[2] + v[2] * cs[3]; return o;
    }
    __device__ __forceinline__ void mid(f32x4 (&acc)[2][2][4][2], const pg8::Unit& u, int wr, int wc, int fr_, int fq_) const {
        int fr = fr_, fq = fq_; asm volatile("" : "+v"(fr), "+v"(fq));
        const bf16_t* gm = (const bf16_t*)(ws + WS_GM); const bf16_t* gd = (const bf16_t*)(ws + WS_GD);
        const int rowbase = u.pm * 256 + wr * 64, cw = wc * 32 + fq * 8;
#pragma unroll
        for (int ai = 0; ai < 2; ++ai)
#pragma unroll
            for (int m = 0; m < 4; ++m) {
                const int row = rowbase + ai * 128 + m * 16 + fr;
#pragma unroll
                for (int bj = 0; bj < 2; ++bj) {
                    const size_t off = (size_t)row * DM + u.pn * 256 + bj * 128 + cw;
                    const u32x4 a = *(const u32x4*)(gm + off), b = *(const u32x4*)(gd + off);
                    f32x4 r0, r1;
                    r0[0] = bf_lo(a.x) * __builtin_amdgcn_rcpf(fmaxf(bf_lo(b.x), 1e-30f)); r0[1] = bf_hi(a.x) * __builtin_amdgcn_rcpf(fmaxf(bf_hi(b.x), 1e-30f));
                    r0[2] = bf_lo(a.y) * __builtin_amdgcn_rcpf(fmaxf(bf_lo(b.y), 1e-30f)); r0[3] = bf_hi(a.y) * __builtin_amdgcn_rcpf(fmaxf(bf_hi(b.y), 1e-30f));
                    r1[0] = bf_lo(a.z) * __builtin_amdgcn_rcpf(fmaxf(bf_lo(b.z), 1e-30f)); r1[1] = bf_hi(a.z) * __builtin_amdgcn_rcpf(fmaxf(bf_hi(b.z), 1e-30f));
                    r1[2] = bf_lo(a.w) * __builtin_amdgcn_rcpf(fmaxf(bf_lo(b.w), 1e-30f)); r1[3] = bf_hi(a.w) * __builtin_amdgcn_rcpf(fmaxf(bf_hi(b.w), 1e-30f));
                    acc[ai][bj][m][0] *= r0; acc[ai][bj][m][1] *= r1;
                }
            }
    }
    __device__ __forceinline__ void operator()(const f32x4 (&acc)[2][2][4][2], const pg8::Unit& u, int wr, int wc, int fr_, int fq_) const {
        int fr = fr_, fq = fq_; asm volatile("" : "+v"(fr), "+v"(fq));
        const int lane = fr + 16 * fq;
        const int rowbase = u.pm * 256 + wr * 64;
        const int cw = wc * 32 + fq * 8;
        if (MEN(0) && mode == M_SWIGLU) {
            float rs[2]; row_scales(rowbase, lane, fr, rs);
            bf16_t* H = (bf16_t*)o0;
#pragma unroll
            for (int ai = 0; ai < 2; ++ai)
#pragma unroll
                for (int m = 0; m < 4; ++m) {
                    const int row = rowbase + ai * 128 + m * 16 + fr; const float r = __shfl(rs[ai], m * 16 + fr);
                    f32x4 h[2];
                    const float cr = -1.4426950408889634f * r, r2 = r * r;
#pragma unroll
                    for (int n = 0; n < 2; ++n) { const f32x4 g = acc[ai][0][m][n], up = acc[ai][1][m][n];
#pragma unroll
                        for (int j = 0; j < 4; ++j) h[n][j] = (g[j] * up[j]) * (r2 * __builtin_amdgcn_rcpf(1.0f + __builtin_amdgcn_exp2f(g[j] * cr))); }
                    *(u32x4*)(H + (size_t)row * FF + u.pn * 128 + cw) = pack8(h[0], h[1]);
                }
        } else if (MEN(1) && mode == M_RESID) {
            const float* res = (const float*)i0; const bf16_t* resb = (const bf16_t*)i0; float* outp = (float*)o0; bf16_t* xb = (bf16_t*)o1; const bool rb16 = np == 0;
#pragma unroll
            for (int ai = 0; ai < 2; ++ai)
#pragma unroll
                for (int m = 0; m < 4; ++m) {
                    const int row = rowbase + ai * 128 + m * 16 + fr; float s = 0.f;
#pragma unroll
                    for (int bj = 0; bj < 2; ++bj) {
                        const size_t off = (size_t)row * DM + u.pn * 256 + bj * 128 + cw;
                        f32x4 a, b;
                        if (rb16) { const u32x4 w = *(const u32x4*)(resb + off); a = (f32x4){bf_lo(w.x), bf_hi(w.x), bf_lo(w.y), bf_hi(w.y)}; b = (f32x4){bf_lo(w.z), bf_hi(w.z), bf_lo(w.w), bf_hi(w.w)}; }
                        else { a = *(const f32x4*)(res + off); b = *(const f32x4*)(res + off + 4); }
                        const f32x4 v0 = a + acc[ai][bj][m][0] * f0, v1 = b + acc[ai][bj][m][1] * f0;
                        if (outp) { *(f32x4*)(outp + off) = v0; *(f32x4*)(outp + off + 4) = v1; }
                        if (xb) *(u32x4*)(xb + off) = pack8(v0, v1);
                        s += (v0[0] * v0[0] + v0[1] * v0[1]) + (v0[2] * v0[2] + v0[3] * v0[3]) + (v1[0] * v1[0] + v1[1] * v1[1]) + (v1[2] * v1[2] + v1[3] * v1[3]);
                    }
                    s += __shfl_xor(s, 16); s += __shfl_xor(s, 32);
                    if (fq == 0) ssq_out[(size_t)row * 16 + u.pn * 4 + wc] = s;
                }
        } else if (MEN(2) && mode == M_WIN) {
            float rs[2]; row_scales(rowbase, lane, fr, rs);
            const int pn = u.pn;
            bf16_t* cq = (bf16_t*)(ws + WS_CQ); bf16_t* ckv = (bf16_t*)(ws + WS_CKV); bf16_t* kr = (bf16_t*)(ws + WS_KR); bf16_t* qd = (bf16_t*)(ws + WS_QD); bf16_t* kd = (bf16_t*)(ws + WS_KD);
            bf16_t* gm = (bf16_t*)(ws + WS_GM); bf16_t* gd = (bf16_t*)(ws + WS_GD); float* ssq_q = (float*)(ws + WS_SSQQ); float* ssq_kv = (float*)(ws + WS_SSQKV);
            const f32x4* tabm = (const f32x4*)(ws + WS_TABM); const f32x4* tabd = (const f32x4*)(ws + WS_TABD);
#pragma unroll
            for (int ai = 0; ai < 2; ++ai)
#pragma unroll
                for (int m = 0; m < 4; ++m) {
                    const int row = rowbase + ai * 128 + m * 16 + fr; const float r = __shfl(rs[ai], m * 16 + fr);
                    f32x4 v[2][2];
#pragma unroll
                    for (int bj = 0; bj < 2; ++bj) { v[bj][0] = acc[ai][bj][m][0] * r; v[bj][1] = acc[ai][bj][m][1] * r; }
                    if (pn == 0) {
                        float s = 0.f;
#pragma unroll
                        for (int bj = 0; bj < 2; ++bj) {
                            *(u32x4*)(cq + (size_t)row * 256 + bj * 128 + cw) = pack8(v[bj][0], v[bj][1]);
#pragma unroll
                            for (int n = 0; n < 2; ++n) s += (v[bj][n][0] * v[bj][n][0] + v[bj][n][1] * v[bj][n][1]) + (v[bj][n][2] * v[bj][n][2] + v[bj][n][3] * v[bj][n][3]);
                        }
                        s += __shfl_xor(s, 16); s += __shfl_xor(s, 32);
                        if (fq == 0) ssq_q[(size_t)row * 4 + wc] = s;
                    } else if (pn == 1) {
                        float s = 0.f;
                        *(u32x4*)(ckv + (size_t)row * 128 + cw) = pack8(v[0][0], v[0][1]);
#pragma unroll
                        for (int n = 0; n < 2; ++n) s += (v[0][n][0] * v[0][n][0] + v[0][n][1] * v[0][n][1]) + (v[0][n][2] * v[0][n][2] + v[0][n][3] * v[0][n][3]);
                        s += __shfl_xor(s, 16); s += __shfl_xor(s, 32);
                        if (fq == 0) ssq_kv[(size_t)row * 4 + wc] = s;
                        if (wc == 0) {
                            const f32x4 c0 = tabm[(size_t)row * 8 + 2 * fq], c1 = tabm[(size_t)row * 8 + 2 * fq + 1];
                            *(u32x4*)(kr + (size_t)row * 32 + fq * 8) = pack8(rope4(v[1][0], c0), rope4(v[1][1], c1));
                        }
                    } else if (pn < 6) {
                        const bool isq = pn < 4; bf16_t* base = isq ? qd : kd; const int coff = (pn - (isq ? 2 : 4)) * 256; const float sc = isq ? scale : 1.0f;
                        const bool rp = ((wc & 1) == 0) && (fq < 2);
                        f32x4 c0 = (f32x4){1.f, 0.f, 1.f, 0.f}, c1 = c0;
                        if (rp) { c0 = tabd[(size_t)row * 4 + 2 * fq]; c1 = tabd[(size_t)row * 4 + 2 * fq + 1]; }
#pragma unroll
                        for (int bj = 0; bj < 2; ++bj)
                            *(u32x4*)(base + (size_t)row * 512 + coff + bj * 128 + cw) = pack8(rope4(v[bj][0], c0) * sc, rope4(v[bj][1], c1) * sc);
                    } else {
                        const bool ism = pn < 10; bf16_t* base = ism ? gm : gd; const int coff = (pn - (ism ? 6 : 10)) * 256;
#pragma unroll
                        for (int bj = 0; bj < 2; ++bj) {
                            f32x4 a, b;
#pragma unroll
                            for (int j = 0; j < 4; ++j) { a[j] = sigmoidf_(v[bj][0][j]); b[j] = sigmoidf_(v[bj][1][j]); }
                            *(u32x4*)(base + (size_t)row * DM + coff + bj * 128 + cw) = pack8(a, b);
                        }
                    }
                }
        } else if (MEN(3) && mode == M_VT) {
            bf16_t* vt = (bf16_t*)o0;
            float cs[2][2][4];
            {
                const int tok = u.pn * 256 + (lane >> 5) * 128 + wc * 32 + (lane & 31);
                const float r = rsqrtf(rowsum(ssq, tok, np) * inv_dim + EPS);
#pragma unroll
                for (int bj = 0; bj < 2; ++bj)
#pragma unroll
                    for (int n = 0; n < 2; ++n)
#pragma unroll
                        for (int j = 0; j < 4; ++j) cs[bj][n][j] = __shfl(r, bj * 32 + fq * 8 + n * 4 + j);
            }
#pragma unroll
            for (int ai = 0; ai < 2; ++ai)
#pragma unroll
                for (int m = 0; m < 4; ++m) {
                    const int f = rowbase + ai * 128 + m * 16 + fr;
#pragma unroll
                    for (int bj = 0; bj < 2; ++bj)
#pragma unroll
                        for (int n = 0; n < 2; ++n) {
                            const f32x4 a = acc[ai][bj][m][n];
                            u32x2 w; w.x = cvtpk(a[0] * cs[bj][n][0], a[1] * cs[bj][n][1]); w.y = cvtpk(a[2] * cs[bj][n][2], a[3] * cs[bj][n][3]);
                            { const int tok = u.pn * 256 + bj * 128 + wc * 32 + (fq >> 1) * 16 + n * 8 + (fq & 1) * 4; *(u32x2*)(vt + ((size_t)(tok >> 6) * 512 + f) * 64 + (tok & 63)) = w; }
                        }
                }
        } else if (MEN(4) && mode == M_Q) {
            float rs[2]; row_scales(rowbase, lane, fr, rs);
            bf16_t* qm = (bf16_t*)o0; const f32x4* tabm = (const f32x4*)(ws + WS_TABM);
#pragma unroll
            for (int ai = 0; ai < 2; ++ai)
#pragma unroll
                for (int m = 0; m < 4; ++m) {
                    const int row = rowbase + ai * 128 + m * 16 + fr; const float r = __shfl(rs[ai], m * 16 + fr) * scale;
                    const f32x4 c0 = tabm[(size_t)row * 8 + 2 * fq], c1 = tabm[(size_t)row * 8 + 2 * fq + 1];
#pragma unroll
                    for (int bj = 0; bj < 2; ++bj) {
                        const int sl = u.pn * 8 + bj * 4 + wc;
                        f32x4 a = acc[ai][bj][m][0] * r, b = acc[ai][bj][m][1] * r;
                        if (sl % 3 == 2) { a = rope4(a, c0); b = rope4(b, c1); }
                        *(u32x4*)(qm + (size_t)row * 768 + u.pn * 256 + bj * 128 + cw) = pack8(a, b);
                    }
                }
        } else if (MEN(5) && mode == M_KN) {
            float rs[2]; row_scales(rowbase, lane, fr, rs);
            bf16_t* kn = (bf16_t*)o0;
#pragma unroll
            for (int ai = 0; ai < 2; ++ai)
#pragma unroll
                for (int m = 0; m < 4; ++m) {
                    const int row = rowbase + ai * 128 + m * 16 + fr; const float r = __shfl(rs[ai], m * 16 + fr);
#pragma unroll
                    for (int bj = 0; bj < 2; ++bj)
                        *(u32x4*)(kn + (size_t)row * 512 + u.pn * 256 + bj * 128 + cw) = pack8(acc[ai][bj][m][0] * r, acc[ai][bj][m][1] * r);
                }
        } else if (MEN(6)) {
            const bf16_t* G = (const bf16_t*)i0; bf16_t* mg = (bf16_t*)o0;
#pragma unroll
            for (int ai = 0; ai < 2; ++ai)
#pragma unroll
                for (int m = 0; m < 4; ++m) {
                    const int row = rowbase + ai * 128 + m * 16 + fr;
#pragma unroll
                    for (int bj = 0; bj < 2; ++bj) {
                        const size_t off = (size_t)row * DM + u.pn * 256 + bj * 128 + cw;
                        const u32x4 g = *(const u32x4*)(G + off);
                        f32x4 a = acc[ai][bj][m][0], b = acc[ai][bj][m][1];
                        a[0] *= fmaxf(bf_lo(g.x), 1e-30f); a[1] *= fmaxf(bf_hi(g.x), 1e-30f); a[2] *= fmaxf(bf_lo(g.y), 1e-30f); a[3] *= fmaxf(bf_hi(g.y), 1e-30f);
                        b[0] *= fmaxf(bf_lo(g.z), 1e-30f); b[1] *= fmaxf(bf_hi(g.z), 1e-30f); b[2] *= fmaxf(bf_lo(g.w), 1e-30f); b[3] *= fmaxf(bf_hi(g.w), 1e-30f);
                        if (mode == M_GATE2) {
                            const u32x4 p = *(const u32x4*)(mg + off);
                            a[0] += bf_lo(p.x); a[1] += bf_hi(p.x); a[2] += bf_lo(p.y); a[3] += bf_hi(p.y);
                            b[0] += bf_lo(p.z); b[1] += bf_hi(p.z); b[2] += bf_lo(p.w); b[3] += bf_hi(p.w);
                        }
                        *(u32x4*)(mg + off) = pack8(a, b);
                    }
                }
        }
    }
};

template <class SrcFn>
__device__ __forceinline__ void cvt_item(SrcFn src, int sstride, const float* gain, int K, bf16_t* WT, LAS float* scr, int item, int nblk, int lane) {
    const int kb = item / nblk, nb = item % nblk, k0 = 64 * kb, n0 = 32 * nb;
    const float* sp = src(n0 + (lane & 31));
    float vv[32];
#pragma unroll
    for (int i = 0; i < 32; ++i) { const int kk = 2 * i + (lane >> 5); vv[i] = sp ? sp[(size_t)(k0 + kk) * sstride] : 0.f; }
    if (gain) {
#pragma unroll
        for (int i = 0; i < 32; ++i) vv[i] *= gain[k0 + 2 * i + (lane >> 5)];
    }
#pragma unroll
    for (int i = 0; i < 32; ++i) scr[(2 * i + (lane >> 5)) * 33 + (lane & 31)] = vv[i];
    asm volatile("s_waitcnt lgkmcnt(0)" ::: "memory");
    const int c = lane & 7;
#pragma unroll
    for (int j = 0; j < 4; ++j) { const int n = (lane >> 3) + 8 * j; const LAS float* s = scr + (8 * c) * 33 + n;
        u32x4 o; o.x = cvtpk(s[0 * 33], s[1 * 33]); o.y = cvtpk(s[2 * 33], s[3 * 33]); o.z = cvtpk(s[4 * 33], s[5 * 33]); o.w = cvtpk(s[6 * 33], s[7 * 33]);
        *(u32x4*)(WT + (size_t)(n0 + n) * K + k0 + 8 * c) = o; }
    asm volatile("s_waitcnt lgkmcnt(0)" ::: "memory");
}

__device__ __forceinline__ void prologue(const KP& p, LAS unsigned char* lds, unsigned char* ws) {
    int tid_l = threadIdx.x; asm volatile("" : "+v"(tid_l));
    const int tid = tid_l, lane = tid & 63, wave = tid >> 6;
    const int gw = blockIdx.x * 8 + wave, NGW = gridDim.x * 8;
    if (blockIdx.x == 0 && tid < 32) ((unsigned*)(ws + WS_CTL))[tid * 64] = 0u;
    if (blockIdx.x == 1 && tid < 192) {
        const int qb = tid / 6, sl = tid % 6; const float c = sl < 2 ? 2.4f * (qb + 1) + 0.5f : (float)(qb + 1);
        int rank = 0;
        for (int j = 0; j < 192; ++j) { const int qj = j / 6, sj = j % 6; const float cj = sj < 2 ? 2.4f * (qj + 1) + 0.5f : (float)(qj + 1); rank += (cj > c || (cj == c && j < tid)) ? 1 : 0; }
        ((int*)(ws + WS_CTL + 32768))[rank] = qb * 8 + sl;
    }
    LAS float* scr = (LAS float*)(lds + wave * 16384);
    constexpr int I_GU = (DM / 64) * (NGU / 32), I_D = (FF / 64) * (DM / 32), I_WIN = (DM / 64) * (NWIN / 32), I_DV = (DM / 64) * (512 / 32), I_UQ = (256 / 64) * (768 / 32),
                  I_UK = (128 / 64) * (512 / 32), I_P = (512 / 64) * (DM / 32), I_O = (DM / 64) * (DM / 32);
    constexpr int NIT = 2 * I_GU + 2 * I_D + I_WIN + I_DV + I_UQ + 2 * I_UK + 2 * I_P + I_O;
    for (int it = gw; it < NIT; it += NGW) {
        int r = it, mat, K, nblk, sstride; const float* gain = nullptr; const float* w0; const float* w1 = nullptr; size_t dst;
        if (r < 2 * I_GU) { const bool sec = r >= I_GU; if (sec) r -= I_GU; mat = 0; K = DM; nblk = NGU / 32; sstride = FF; gain = sec ? p.n2 : p.n1; w0 = sec ? p.wg2 : p.wg1; w1 = sec ? p.wu2 : p.wu1; dst = sec ? WS_W2GU : WS_W1GU; }
        else if ((r -= 2 * I_GU) < 2 * I_D) { const bool sec = r >= I_D; if (sec) r -= I_D; mat = 1; K = FF; nblk = DM / 32; sstride = DM; w0 = sec ? p.wd2 : p.wd1; dst = sec ? WS_W2D : WS_W1D; }
        else if ((r -= 2 * I_D) < I_WIN) { mat = 2; K = DM; nblk = NWIN / 32; sstride = 4000; gain = p.nmix; w0 = p.win; dst = WS_WIN; }
        else if ((r -= I_WIN) < I_DV) { mat = 1; K = DM; nblk = 512 / 32; sstride = 4000; gain = p.nmix; w0 = p.win + 1440; dst = WS_WDV; }
        else if ((r -= I_DV) < I_UQ) { mat = 3; K = 256; nblk = 768 / 32; sstride = 768; gain = p.nq; w0 = p.wuq; dst = WS_WUQ; }
        else if ((r -= I_UQ) < 2 * I_UK) { const bool isv = r >= I_UK; if (isv) r -= I_UK; mat = 4; K = 128; nblk = 512 / 32; sstride = 1024; gain = p.nkv; w0 = p.wukv + (isv ? 64 : 0); dst = isv ? WS_WUV : WS_WUK; }
        else if ((r -= 2 * I_UK) < 2 * I_P) { const bool sec = (r / (DM / 32)) >= 8; mat = 1; K = 1024; nblk = DM / 32; sstride = DM; w0 = sec ? p.pd - (size_t)512 * DM : p.pm; dst = WS_PM; }
        else { r -= 2 * I_P; mat = 1; K = DM; nblk = DM / 32; sstride = DM; w0 = p.wo; dst = WS_WO; }
        cvt_item([=](int n) -> const float* {
                     if (mat == 0) { const int t = n >> 8, w = n & 255; return w < 128 ? w0 + t * 128 + w : w1 + t * 128 + (w - 128); }
                     if (mat == 1) return w0 + n;
                     if (mat == 2) {
                         if (n < 384) return w0 + n;
                         if (n < 416) { const int q = n - 384; return w0 + 384 + (q & 1) * 16 + (q >> 1); }
                         if (n < 512) return nullptr;
                         if (n < 1536) { const int c = n - 512, base = c < 512 ? 416 : 928, cc = c & 511, h = cc >> 6, ww = cc & 63; const int sw = ww < 16 ? (ww & 1) * 8 + (ww >> 1) : ww; return w0 + base + h * 64 + sw; }
                         if (n < 2560) return w0 + 1952 + (n - 1536);
                         return w0 + 2976 + (n - 2560);
                     }
                     if (mat == 3) { const int h = n / 96, ww = n % 96; if (ww < 64) return w0 + h * 96 + ww; const int q = ww - 64; return w0 + h * 96 + 64 + (q & 1) * 16 + (q >> 1); }
                     return w0 + (n >> 6) * 128 + (n & 63); },
                 sstride, gain, K, (bf16_t*)(ws + dst), scr, r, nblk, lane);
    }
    bf16_t* xb = (bf16_t*)(ws + WS_XB); float* ssqa = (float*)(ws + WS_SSQA);
    for (int m = gw; m < T; m += NGW) {
        const f32x4* xr = (const f32x4*)(p.x + (size_t)m * DM) + lane;
        f32x4 v[4]; float s = 0.f;
#pragma unroll
        for (int j = 0; j < 4; ++j) { v[j] = xr[64 * j]; s += (v[j][0] * v[j][0] + v[j][1] * v[j][1]) + (v[j][2] * v[j][2] + v[j][3] * v[j][3]); }
        s = wave_sum(s);
        u32x2* o8 = (u32x2*)(xb + (size_t)m * DM) + lane;
#pragma unroll
        for (int j = 0; j < 4; ++j) { u32x2 w; w.x = cvtpk(v[j][0], v[j][1]); w.y = cvtpk(v[j][2], v[j][3]); o8[64 * j] = w; }
        if (lane < 16) ssqa[(size_t)m * 16 + lane] = lane == 0 ? s : 0.f;
    }
    f32x2* tabm = (f32x2*)(ws + WS_TABM); f32x2* tabd = (f32x2*)(ws + WS_TABD);
    for (int idx = blockIdx.x * 512 + tid; idx < T * 24; idx += gridDim.x * 512) {
        const int t = idx / 24, i = idx % 24;
        const float invf = i < 16 ? p.invf_m[i] : p.invf_d[i - 16];
        const double rev = (double)p.pos[t] * (double)invf * 0.15915494309189535;
        const float fr = (float)(rev - rint(rev));
        const f32x2 cs = (f32x2){__builtin_amdgcn_cosf(fr), __builtin_amdgcn_sinf(fr)};
        if (i < 16) tabm[(size_t)t * 16 + i] = cs; else tabd[(size_t)t * 8 + (i - 16)] = cs;
    }
}

__device__ __forceinline__ int crow(int r, int hi) { return (r & 3) + 8 * (r >> 2) + 4 * hi; }
#define GAS __attribute__((address_space(1)))
#define GLD16(p) (*(const GAS u32x4*)(p))
#define MFMA32(a, b, c) __builtin_amdgcn_mfma_f32_32x32x16_bf16((a), (b), (c), 0, 0, 0)

__device__ __forceinline__ float max3f(float a, float b, float c) { float r; asm("v_max3_f32 %0, %1, %2, %3" : "=v"(r) : "v"(a), "v"(b), "v"(c)); return r; }
__device__ __forceinline__ float max2f(float a, float b) { float r; asm("v_max_f32_e32 %0, %1, %2" : "=v"(r) : "v"(a), "v"(b)); return r; }
__device__ __forceinline__ float xhalf_max(float v) { auto rr = __builtin_amdgcn_permlane32_swap(__float_as_uint(v), __float_as_uint(v), false, false); return __builtin_fmaxf(__uint_as_float(rr[0]), __uint_as_float(rr[1])); }
__device__ __forceinline__ float xhalf_sum(float v) { auto rr = __builtin_amdgcn_permlane32_swap(__float_as_uint(v), __float_as_uint(v), false, false); return __uint_as_float(rr[0]) + __uint_as_float(rr[1]); }

__device__ __forceinline__ void glds16(const void* gsrc, unsigned lds_dst) {
    unsigned keep;
    asm volatile("s_mov_b32 %0, m0\n\ts_mov_b32 m0, %2\n\ts_nop 0\n\tglobal_load_lds_dwordx4 %1, off\n\ts_mov_b32 m0, %0" : "=&s"(keep) : "v"(gsrc), "s"(lds_dst) : "memory");
}
template <int DQK, int DV, bool MLA>
__device__ __forceinline__ void attn_pass(LAS unsigned char* lds, const bf16_t* Qrow, const bf16_t* K0, int pitchK, const bf16_t* KrB, const bf16_t* Vt0, int NT, int q0w,
                                          f32x16 (&o)[DV / 32], float& l_out, int tid) {
    constexpr int KB = 8192, KRB = 4096, VB = DV * 128, NVC = DV / 64, ND = DQK / 16, NDV = DV / 32;
    constexpr int KROFF = 4 * KB, VOFF = 4 * KB + (MLA ? 4 * KRB : 0);
    constexpr int NP = 1 + NVC + (MLA ? 1 : 0);
    constexpr int NG = 4 * NDV, EPG = 32 / NG;
    constexpr float THR = 8.0f;
    static_assert(NP == 3, "the counted waits below assume three pieces per wave per tile");
    const int lane = tid & 63, r32 = lane & 31, hi = lane >> 5;
    const int wid = __builtin_amdgcn_readfirstlane(tid >> 6);
    const unsigned lds0 = (unsigned)(uintptr_t)lds;
    bf16x8 q[ND];
#pragma unroll
    for (int d0 = 0; d0 < ND; ++d0) q[d0] = *(const GAS bf16x8*)(Qrow + 16 * d0 + 8 * hi);
#pragma unroll
    for (int d = 0; d < NDV; ++d)
#pragma unroll
        for (int r = 0; r < 16; ++r) o[d][r] = 0.f;
    float m = 0.f, l = 0.f;
    f32x16 negm;
#pragma unroll
    for (int r = 0; r < 16; ++r) negm[r] = 0.f;
#pragma unroll
    for (int d0 = 0; d0 < ND; ++d0) asm volatile("" : "+v"(q[d0]));
    const bf16_t* ksrc; const bf16_t* rsrc = nullptr; const bf16_t* vsrc[NVC];
    { const int row = 8 * wid + (lane >> 3), c = (lane & 7) ^ ((row >> 1) & 7); ksrc = K0 + (size_t)row * pitchK + c * 8; }
    if (MLA) { const int row = 16 * (wid & 3) + (lane >> 2), c = (lane & 3) ^ ((row >> 2) & 3); rsrc = KrB + (size_t)row * 32 + c * 8; }
#pragma unroll
    for (int j = 0; j < NVC; ++j) { const int row = 8 * (wid + 8 * j) + (lane >> 3), c = (lane & 7) ^ ((row >> 1) & 7); vsrc[j] = Vt0 + (size_t)row * 64 + c * 8; }
#define ATT_DMA_K(tt, kslot) do { \
        glds16(ksrc + (size_t)(tt) * 64 * pitchK, (unsigned)__builtin_amdgcn_readfirstlane(lds0 + (kslot) * KB + wid * 1024)); \
        if (MLA) glds16(rsrc + (size_t)(tt) * 64 * 32, (unsigned)__builtin_amdgcn_readfirstlane(lds0 + KROFF + (kslot) * KRB + (wid & 3) * 1024)); } while (0)
#define ATT_DMA_V(tt, vslot) do { \
        _Pragma("unroll") for (int j = 0; j < NVC; ++j) glds16(vsrc[j] + (size_t)(tt) * (512 * 64), (unsigned)__builtin_amdgcn_readfirstlane(lds0 + VOFF + (vslot) * VB + (wid + 8 * j) * 1024)); } while (0)
    const int xs = (r32 >> 1) & 7;
    const int yk = (xs ^ hi) << 4;
    const int yr = (((r32 >> 2) & 3) ^ hi) << 4;
    bf16x8 kf[2 * ND];
#define ATT_KLOAD(kslot) do { \
        const LAS unsigned char* kp_ = lds + (kslot) * KB + r32 * 128; \
        _Pragma("unroll") for (int d0 = 0; d0 < ND; ++d0) { \
            if (MLA && d0 >= 4) { const LAS unsigned char* rp_ = lds + KROFF + (kslot) * KRB + r32 * 64 + ((32 * (d0 - 4)) ^ yr); kf[2 * d0] = *(const LAS bf16x8*)rp_; kf[2 * d0 + 1] = *(const LAS bf16x8*)(rp_ + 32 * 64); } \
            else { kf[2 * d0] = *(const LAS bf16x8*)(kp_ + ((32 * d0) ^ yk)); kf[2 * d0 + 1] = *(const LAS bf16x8*)(kp_ + 32 * 128 + ((32 * d0) ^ yk)); } } } while (0)
    ATT_DMA_K(0, 0); ATT_DMA_V(0, 0); ATT_DMA_K(1, 1); ATT_DMA_V(1, 1); ATT_DMA_K(2, 2);
    asm volatile("s_waitcnt vmcnt(0)" ::: "memory");
    __builtin_amdgcn_s_barrier();
    asm volatile("" ::: "memory");
    ATT_KLOAD(0);
    bf16x8 pf[4];
    bool pend = false;
    int vs_prev = 0;
#define PV_D(g) (NDV == 4 ? (((g) & 1) + 2 * ((g) >> 3)) : ((g) & 1))
#define PV_KS(g) (((g) >> 1) & 3)
#define PV_IDX(g) (((g) & 1) * 4 + PV_KS(g))
#define VFRAG(vp, d, ks) (*(const LAS bf16x8*)((vp) + (32 * (d)) * 128 + ((32 * (ks)) ^ yk)))
    for (int t = 0; t < NT; ++t) {
        const bool far = t + 3 < NT;
        if (far) ATT_DMA_K(t + 3, (t + 3) & 3);
        if (t + 2 < NT) ATT_DMA_V(t + 2, (t + 2) & 3);
        const LAS unsigned char* vp = lds + VOFF + vs_prev * VB + r32 * 128;
        if (64 * t <= q0w + 31) {
            f32x16 s0, s1;
            if constexpr (MLA) { s0 = negm; s1 = negm; }
            else {
#pragma unroll
                for (int r = 0; r < 16; ++r) { s0[r] = 0.f; s1[r] = 0.f; }
            }
            __builtin_amdgcn_s_setprio(1);
#pragma unroll
            for (int d0 = 0; d0 < ND; ++d0) { s0 = MFMA32(kf[2 * d0], q[d0], s0); s1 = MFMA32(kf[2 * d0 + 1], q[d0], s1); }
            __builtin_amdgcn_s_setprio(0);
            __builtin_amdgcn_sched_barrier(0);
            if (t + 1 < NT) ATT_KLOAD((t + 1) & 3);
            bf16x8 vf[8];
            if (pend) {
#pragma unroll
                for (int g = 0; g < 8; ++g) vf[PV_IDX(g)] = VFRAG(vp, PV_D(g), PV_KS(g));
            }
            __builtin_amdgcn_sched_barrier(0);
            if (64 * t + 63 > q0w) {
                int hi_l = hi; asm volatile("" : "+v"(hi_l));
                const int qrow = q0w + r32, kb0 = 64 * t + 4 * hi_l;
#pragma unroll
                for (int r = 0; r < 16; ++r) { const int kv = kb0 + (r & 3) + 8 * (r >> 2); if (kv > qrow) s0[r] = -INFINITY; if (kv + 32 > qrow) s1[r] = -INFINITY; }
            }
            float mx;
            asm volatile("s_nop 11" : "+v"(s0), "+v"(s1));
            {
                float a = max3f(s0[0], s0[1], s1[0]), b = max3f(s0[2], s0[3], s1[1]); a = max3f(a, s1[2], s1[3]);
#pragma unroll
                for (int r = 4; r < 16; r += 4) { a = max3f(a, s0[r], s0[r + 1]); b = max3f(b, s0[r + 2], s0[r + 3]); a = max3f(a, s1[r], s1[r + 1]); b = max3f(b, s1[r + 2], s1[r + 3]); }
                mx = xhalf_max(__builtin_fmaxf(a, b)) - (MLA ? 0.f : m);
            }
            if (t == 0 || __any(mx > THR)) {
                if (pend) {
#pragma unroll
                    for (int g = 0; g < NG; ++g) {
                        o[PV_D(g)] = MFMA32(vf[PV_IDX(g)], pf[PV_KS(g)], o[PV_D(g)]);
                        if (NDV == 4 && g < 8) vf[PV_IDX(g)] = VFRAG(vp, PV_D(g) + 2, PV_KS(g));
                    }
                    pend = false;
                }
                const float dl = t == 0 ? mx : fmaxf(mx, 0.f);
                m += dl;
                if constexpr (MLA) {
#pragma unroll
                    for (int r = 0; r < 16; ++r) { s0[r] -= dl; s1[r] -= dl; negm[r] = -m; }
                }
                const float a = __builtin_amdgcn_exp2f(-dl);
                l *= a;
#pragma unroll
                for (int d = 0; d < NDV; ++d)
#pragma unroll
                    for (int r = 0; r < 16; ++r) o[d][r] *= a;
            }
            float ps = 0.f;
            u32x4 pw[4];
            float ps1 = 0.f;
            if (pend) {
#pragma unroll
                for (int g = 0; g <= NG; ++g) {
                    if (g < NG) {
                        o[PV_D(g)] = MFMA32(vf[PV_IDX(g)], pf[PV_KS(g)], o[PV_D(g)]);
                        if (NDV == 4 && g < 8) vf[PV_IDX(g)] = VFRAG(vp, PV_D(g) + 2, PV_KS(g));
#pragma unroll
                        for (int e = g * EPG; e < (g + 1) * EPG; ++e) { if (e < 16) s0[e] = __builtin_amdgcn_exp2f(MLA ? s0[e] : s0[e] - m); else s1[e - 16] = __builtin_amdgcn_exp2f(MLA ? s1[e - 16] : s1[e - 16] - m); }
                    }
                    if (g > 0) {
#pragma unroll
                        for (int e = (g - 1) * EPG; e < g * EPG; ++e) {
                            const float v = e < 16 ? s0[e] : s1[e - 16];
                            if (e & 1) ps1 += v; else ps += v;
                            if (e & 1) { const int j = e >> 1; pw[j >> 2][j & 3] = e < 16 ? cvtpk(s0[e - 1], s0[e]) : cvtpk(s1[e - 17], s1[e - 16]); }
                        }
                    }
                    __builtin_amdgcn_sched_barrier(0);
                }
            } else {
                float m2 = MLA ? 0.f : m; asm volatile("" : "+v"(m2));
#pragma unroll
                for (int e = 0; e < 32; ++e) {
                    if (e < 16) { s0[e] = __builtin_amdgcn_exp2f(MLA ? s0[e] + m2 : s0[e] - m2); ps += s0[e]; } else { s1[e - 16] = __builtin_amdgcn_exp2f(MLA ? s1[e - 16] + m2 : s1[e - 16] - m2); ps += s1[e - 16]; }
                    if (e & 1) { const int j = e >> 1; pw[j >> 2][j & 3] = e < 16 ? cvtpk(s0[e - 1], s0[e]) : cvtpk(s1[e - 17], s1[e - 16]); }
                }
            }
            l += ps + ps1;
#pragma unroll
            for (int k = 0; k < 4; ++k) pf[k] = __builtin_bit_cast(bf16x8, pw[k]);
            pend = true;
        } else if (pend) {
            bf16x8 vf[8];
#pragma unroll
            for (int g = 0; g < 8; ++g) vf[PV_IDX(g)] = VFRAG(vp, PV_D(g), PV_KS(g));
#pragma unroll
            for (int g = 0; g < NG; ++g) {
                o[PV_D(g)] = MFMA32(vf[PV_IDX(g)], pf[PV_KS(g)], o[PV_D(g)]);
                if (NDV == 4 && g < 8) vf[PV_IDX(g)] = VFRAG(vp, PV_D(g) + 2, PV_KS(g));
            }
            pend = false;
        }
        vs_prev = t & 3;
        if (far) asm volatile("s_waitcnt vmcnt(3) lgkmcnt(0)" ::: "memory"); else asm volatile("s_waitcnt vmcnt(0) lgkmcnt(0)" ::: "memory");
        __builtin_amdgcn_s_barrier();
        asm volatile("" ::: "memory");
    }
    if (pend) {
        const LAS unsigned char* vp = lds + VOFF + vs_prev * VB + r32 * 128;
        bf16x8 vf[8];
#pragma unroll
        for (int g = 0; g < 8; ++g) vf[PV_IDX(g)] = VFRAG(vp, PV_D(g), PV_KS(g));
#pragma unroll
        for (int g = 0; g < NG; ++g) {
            o[PV_D(g)] = MFMA32(vf[PV_IDX(g)], pf[PV_KS(g)], o[PV_D(g)]);
            if (NDV == 4 && g < 8) vf[PV_IDX(g)] = VFRAG(vp, PV_D(g) + 2, PV_KS(g));
        }
    }
#undef PV_D
#undef PV_KS
#undef PV_IDX
#undef VFRAG
#undef ATT_DMA_K
#undef ATT_DMA_V
#undef ATT_KLOAD
    asm volatile("s_waitcnt lgkmcnt(0)" ::: "memory");
    __builtin_amdgcn_s_barrier();
    asm volatile("" ::: "memory");
    l_out = xhalf_sum(l);
}

__device__ __forceinline__ void attention_phase(const KP& p, LAS unsigned char* lds, unsigned char* ws, int rep) {
    int tid_l = threadIdx.x; asm volatile("" : "+v"(tid_l));
    const int tid0 = tid_l;
    const int xcd = blockIdx.x & 7;
    unsigned* counter = (unsigned*)(ws + WS_CTL) + (rep * 8 + xcd) * 64;
    LAS unsigned* wq = (LAS unsigned*)(lds + LDS_STAGE);
    const float lam = __expf(wave_sum(p.lq1[tid0 & 63] * p.lk1[tid0 & 63])) - __expf(wave_sum(p.lq2[tid0 & 63] * p.lk2[tid0 & 63])) + p.lam_init;
    for (;;) {
        if (tid0 == 0) *wq = atomicAdd(counter, 1u);
        __syncthreads();
        const unsigned u = *wq;
        __syncthreads();
        if (u >= (unsigned)(NUNITS / 8)) break;
        int tid = tid_l; asm volatile("" : "+v"(tid));
        const int lane = tid & 63, r32 = lane & 31, hi = lane >> 5, wid = tid >> 6;
        const int code = ((const int*)(ws + WS_CTL + 32768))[u];
        const int qb = code >> 3, sidx = code & 7;
        const int w = sidx < 2 ? 2 * xcd + sidx : 16 + 4 * xcd + (sidx - 2);
        const int NT = 4 * (qb + 1), q0w = qb * 256 + wid * 32;
        if (w < 16) {
            const int b = w >> 2, h = w & 3; const size_t rb = (size_t)b * SEQ;
            const bf16_t* Qd = (const bf16_t*)(ws + WS_QD); const bf16_t* Kd = (const bf16_t*)(ws + WS_KD); const bf16_t* Vt = (const bf16_t*)(ws + WS_VTD) + ((size_t)(b * (SEQ / 64)) * 512 + h * 128) * 64;
            bf16_t* yo = ((bf16_t*)p.out) + (rb + q0w + r32) * 1024 + 512 + h * 128;
            {
                f32x16 oA[4]; float lA;
                attn_pass<64, 128, false>(lds, Qd + (rb + q0w + r32) * 512 + (2 * h) * 64, Kd + rb * 512 + (2 * h) * 64, 512, nullptr, Vt, NT, q0w, oA, lA, tid);
                const float ia = 1.0f / lA;
#pragma unroll
                for (int d = 0; d < 4; ++d)
#pragma unroll
                    for (int g = 0; g < 4; ++g) {
                        u32x2 wv; wv.x = cvtpk(oA[d][4 * g] * ia, oA[d][4 * g + 1] * ia); wv.y = cvtpk(oA[d][4 * g + 2] * ia, oA[d][4 * g + 3] * ia);
                        *(GAS u32x2*)(yo + 32 * d + 8 * g + 4 * hi) = wv;
                    }
            }
            f32x16 oB[4]; float lB;
            attn_pass<64, 128, false>(lds, Qd + (rb + q0w + r32) * 512 + (2 * h + 1) * 64, Kd + rb * 512 + (2 * h + 1) * 64, 512, nullptr, Vt, NT, q0w, oB, lB, tid);
            const float ib = lam / lB;
            float ss = 0.f;
#pragma unroll
            for (int d = 0; d < 4; ++d)
#pragma unroll
                for (int g = 0; g < 4; ++g) {
                    const u32x2 a = *(const GAS u32x2*)(yo + 32 * d + 8 * g + 4 * hi);
                    const float v0 = bf_lo(a.x) - oB[d][4 * g] * ib, v1 = bf_hi(a.x) - oB[d][4 * g + 1] * ib, v2 = bf_lo(a.y) - oB[d][4 * g + 2] * ib, v3 = bf_hi(a.y) - oB[d][4 * g + 3] * ib;
                    oB[d][4 * g] = v0; oB[d][4 * g + 1] = v1; oB[d][4 * g + 2] = v2; oB[d][4 * g + 3] = v3;
                    ss += (v0 * v0 + v1 * v1) + (v2 * v2 + v3 * v3);
                }
            ss = xhalf_sum(ss);
            const float rn = rsqrtf(ss * (1.0f / 128.0f) + EPS) * p.one_m_lam;
#pragma unroll
            for (int d = 0; d < 4; ++d)
#pragma unroll
                for (int g = 0; g < 4; ++g) {
                    const int dd = 32 * d + 8 * g + 4 * hi;
                    const f32x4 sg = *(const f32x4*)(p.subln + dd);
                    u32x2 wv; wv.x = cvtpk(oB[d][4 * g] * rn * sg[0], oB[d][4 * g + 1] * rn * sg[1]); wv.y = cvtpk(oB[d][4 * g + 2] * rn * sg[2], oB[d][4 * g + 3] * rn * sg[3]);
                    *(GAS u32x2*)(yo + dd) = wv;
                }
        } else {
            const int b = (w - 16) >> 3, h = (w - 16) & 7; const size_t rb = (size_t)b * SEQ;
            const bf16_t* Qm = (const bf16_t*)(ws + WS_QM); const bf16_t* Kn = (const bf16_t*)(ws + WS_KN); const bf16_t* Kr = (const bf16_t*)(ws + WS_KR) + rb * 32;
            const bf16_t* Vt = (const bf16_t*)(ws + WS_VTM) + ((size_t)(b * (SEQ / 64)) * 512 + h * 64) * 64;
            f32x16 oM[2]; float lM;
            attn_pass<96, 64, true>(lds, Qm + (rb + q0w + r32) * 768 + h * 96, Kn + rb * 512 + h * 64, 512, Kr, Vt, NT, q0w, oM, lM, tid);
            const float il = 1.0f / lM;
            bf16_t* yo = ((bf16_t*)p.out) + (rb + q0w + r32) * 1024 + h * 64;
#pragma unroll
            for (int d = 0; d < 2; ++d)
#pragma unroll
                for (int g = 0; g < 4; ++g) {
                    const int dd = 32 * d + 8 * g + 4 * hi;
                    u32x2 wv; wv.x = cvtpk(oM[d][4 * g] * il, oM[d][4 * g + 1] * il); wv.y = cvtpk(oM[d][4 * g + 2] * il, oM[d][4 * g + 3] * il);
                    *(u32x2*)(yo + dd) = wv;
                }
        }
    }
}

__device__ __forceinline__ void final_phase(const KP& p, unsigned char* ws) {
    int tid_l = threadIdx.x; asm volatile("" : "+v"(tid_l));
    const int tid = tid_l, lane = tid & 63, wave = tid >> 6;
    const int gw = blockIdx.x * 8 + wave, NGW = gridDim.x * 8;
    const float* ssq = (const float*)(ws + WS_SSQD);
    f32x4 g[4];
#pragma unroll
    for (int j = 0; j < 4; ++j) g[j] = ((const f32x4*)p.nfin)[lane + 64 * j];
    const bf16_t* xb = (const bf16_t*)(ws + WS_XB);
    for (int m = gw; m < T; m += NGW) {
        const float rs = rsqrtf(Epi::rowsum(ssq, m, 16) * (1.0f / DM) + EPS);
        const u32x2* xr = (const u32x2*)(xb + (size_t)m * DM) + lane;
        f32x4* orow = (f32x4*)(p.out + (size_t)m * DM) + lane;
#pragma unroll
        for (int j = 0; j < 4; ++j) { const u32x2 w = xr[64 * j]; f32x4 v = (f32x4){bf_lo(w.x), bf_hi(w.x), bf_lo(w.y), bf_hi(w.y)}; v = v * rs * g[j]; orow[64 * j] = v; }
    }
}

#define XB_TMO      128
#define XB_XCNT(j)  (256  + 64 * (j))
#define XB_XSUB(j)  (1280 + 64 * (j))
#define XB_XGEN(j)  (2304 + 64 * (j))
#define XB_TOP      3328
#define XB_TOPGEN   3392
#define XCD_BAR_WORDS 3456
#define XB_SPIN_CAP (1u << 18)

__device__ __forceinline__ unsigned xb_ld(unsigned* p)              { return __hip_atomic_load(p, __ATOMIC_RELAXED, __HIP_MEMORY_SCOPE_AGENT); }
__device__ __forceinline__ unsigned xb_add(unsigned* p, unsigned v) { return __hip_atomic_fetch_add(p, v, __ATOMIC_RELAXED, __HIP_MEMORY_SCOPE_AGENT); }
__device__ __forceinline__ unsigned xb_xcc_id() { return (unsigned)__builtin_amdgcn_s_getreg((3 << 11) | 20) & 0xFu; }
#define XB_SPIN(cond, bar) do { unsigned _sp = 0; while (cond) { __builtin_amdgcn_s_sleep(1); \
    if ((++_sp & 255u) == 0u) { if (xb_ld(&(bar)[XB_TMO])) break; if (_sp > XB_SPIN_CAP) { atomicAdd(&(bar)[XB_TMO], 1u); break; } } } } while (0)

struct XcdBarrier {
    unsigned* bar; unsigned x;
    volatile LAS unsigned* st;
};

__device__ __forceinline__ XcdBarrier xcd_barrier_post(unsigned* bar, volatile LAS unsigned* st) {
    XcdBarrier b; b.bar = bar; b.x = xb_xcc_id(); b.st = st;
    if (threadIdx.x == 0) (void)xb_add(&bar[XB_XCNT(b.x)], 1u);
    return b;
}
__device__ __forceinline__ void xcd_barrier_complete(unsigned* bar, unsigned x, unsigned& nloc, unsigned& nx) {
    const unsigned G = gridDim.x * gridDim.y * gridDim.z;
    unsigned sum, cnt, mine, sp = 0u;
    for (;;) {
        sum = 0u; cnt = 0u; mine = 0u;
#pragma unroll
        for (unsigned j = 0; j < 16; ++j) { const unsigned c = xb_ld(&bar[XB_XCNT(j)]); sum += c; cnt += (c > 0u) ? 1u : 0u; mine = (j == x) ? c : mine; }
        if (sum == G) break;
        __builtin_amdgcn_s_sleep(1);
        if ((++sp & 255u) == 0u) { if (xb_ld(&bar[XB_TMO])) break; if (sp > XB_SPIN_CAP) { atomicAdd(&bar[XB_TMO], 1u); break; } }
    }
    nloc = mine > 0u ? mine : 1u; nx = cnt > 0u ? cnt : 1u;
}

__device__ __forceinline__ void xcd_barrier(const XcdBarrier& b) {
    asm volatile("s_waitcnt vmcnt(0)" ::: "memory");
    __syncthreads();
    if (threadIdx.x == 0) {
        unsigned* bar = b.bar;
        __builtin_amdgcn_s_waitcnt(0);
        unsigned nloc = b.st[0], nx = b.st[1];
        if (nloc == 0u) { xcd_barrier_complete(bar, b.x, nloc, nx); b.st[0] = nloc; b.st[1] = nx; }
        const unsigned old = xb_add(&bar[XB_XSUB(b.x)], 1u);
        const unsigned gen = old / nloc;
        if (old + 1u == (gen + 1u) * nloc) {
            __builtin_amdgcn_fence(__ATOMIC_RELEASE, "agent");
            asm volatile("s_waitcnt vmcnt(0)" ::: "memory");
            const unsigned og = xb_add(&bar[XB_TOP], 1u);
            const unsigned tg = og / nx;
            if (og + 1u == (tg + 1u) * nx) xb_add(&bar[XB_TOPGEN], 1u);
            else XB_SPIN(xb_ld(&bar[XB_TOPGEN]) == tg, bar);
            __builtin_amdgcn_fence(__ATOMIC_ACQUIRE, "agent");
            xb_add(&bar[XB_XGEN(b.x)], 1u);
            asm volatile("s_waitcnt vmcnt(0)" ::: "memory");
        } else {
            XB_SPIN(xb_ld(&bar[XB_XGEN(b.x)]) == gen, bar);
            __builtin_amdgcn_fence(__ATOMIC_ACQUIRE, "agent");
            asm volatile("s_waitcnt vmcnt(0)" ::: "memory");
        }
    }
    __syncthreads();
}

enum { ST_PRO = 0, ST_GEMM = 1, ST_ATT = 2, ST_FIN = 3 };
#ifndef REP_STEP
#define REP_STEP -1
#endif
#ifndef N_LAUNCH_SPLIT
#define N_LAUNCH_SPLIT 0
#endif

template <bool COOP>
__global__ void __launch_bounds__(512) fwd(KP p, int step_lo, int step_hi) {
    extern __shared__ __attribute__((aligned(16))) unsigned char lds_raw[];
    LAS unsigned char* lds = (LAS unsigned char*)lds_raw;
    volatile LAS unsigned* bst = (volatile LAS unsigned*)(lds + LDS_STAGE + 64);
    if (threadIdx.x < 2) bst[threadIdx.x] = 0u;
    __syncthreads();
    XcdBarrier gbar; gbar.bar = nullptr; gbar.x = 0; gbar.st = nullptr;
    if constexpr (COOP) gbar = xcd_barrier_post((unsigned*)(p.ws + WS_BAR), bst);
    if constexpr (COOP) { if (step_lo < 0) cg::this_grid().sync(); }
    for (int st = step_lo; st < step_hi; ++st) {
      const bool sync_after = !(st == 3 || st == 5 || st == 6 || st == 9 || st == 14);
      for (int rep = 0; rep < (st == REP_STEP ? 2 : 1); ++rep) {
        size_t wz = 0; asm volatile("" : "+s"(wz));
        unsigned char* ws = p.ws + wz;
        const int kind = st == 0 ? ST_PRO : st == 8 ? ST_ATT : st == 14 ? ST_FIN : ST_GEMM;
        const int job = st < 8 ? st - 1 : st - 2;
#ifndef NO_PRO
        if (kind == ST_PRO) prologue(p, lds, ws);
        else
#endif
#ifndef NO_ATT
        if (kind == ST_ATT) attention_phase(p, lds, ws, rep);
        else
#endif
        if (kind == ST_FIN) final_phase(p, ws);
        else {
            pg8::Gemm g; Epi E;
            E.mode = 0; E.np = 16; E.inv_dim = 1.0f / DM; E.f0 = 0.f; E.ssq = nullptr; E.i0 = nullptr; E.o0 = nullptr; E.o1 = nullptr; E.ssq_out = nullptr;
            E.ws = ws; E.scale = 1.f; E.mid_at = -1;
            const bf16_t* XB = (const bf16_t*)(ws + WS_XB); const bf16_t* HB = (const bf16_t*)(ws + WS_H);
            switch (job) {
            case 0:  g = {XB, (const bf16_t*)(ws + WS_W1GU), T, NGU, DM}; E.mode = M_SWIGLU; E.ssq = (const float*)(ws + WS_SSQA); E.o0 = ws + WS_H; break;
            case 1:  g = {HB, (const bf16_t*)(ws + WS_W1D), T, DM, FF}; E.mode = M_RESID; E.f0 = 0.5f; E.np = 0; E.i0 = ws + WS_XB; E.o0 = nullptr; E.o1 = ws + WS_XB; E.ssq_out = (float*)(ws + WS_SSQB); break;
            case 2:  g = {XB, (const bf16_t*)(ws + WS_WIN), T, NWIN, DM}; E.mode = M_WIN; E.ssq = (const float*)(ws + WS_SSQB); E.scale = p.scale_d; break;
            case 3:  g = {(const bf16_t*)(ws + WS_WDV), XB, 512, T, DM}; E.mode = M_VT; E.ssq = (const float*)(ws + WS_SSQB); E.o0 = ws + WS_VTD; break;
            case 4:  g = {(const bf16_t*)(ws + WS_CQ), (const bf16_t*)(ws + WS_WUQ), T, 768, 256}; E.mode = M_Q; E.ssq = (const float*)(ws + WS_SSQQ); E.np = 4; E.inv_dim = 1.0f / 256; E.o0 = ws + WS_QM; E.scale = p.scale_m; break;
            case 5:  g = {(const bf16_t*)(ws + WS_CKV), (const bf16_t*)(ws + WS_WUK), T, 512, 128}; E.mode = M_KN; E.ssq = (const float*)(ws + WS_SSQKV); E.np = 4; E.inv_dim = 1.0f / 128; E.o0 = ws + WS_KN; break;
            case 6:  g = {(const bf16_t*)(ws + WS_WUV), (const bf16_t*)(ws + WS_CKV), 512, T, 128}; E.mode = M_VT; E.ssq = (const float*)(ws + WS_SSQKV); E.np = 4; E.inv_dim = 1.0f / 128; E.o0 = ws + WS_VTM; break;
            case 7:  g = {(const bf16_t*)p.out, (const bf16_t*)(ws + WS_PM), T, DM, 1024}; E.mode = M_GATE1; E.i0 = ws + WS_GD; E.o0 = ws + WS_MG; E.mid_at = 8; break;
            case 8:  g = {(const bf16_t*)p.out, (const bf16_t*)(ws + WS_PM), 0, DM, 1024}; E.mode = M_GATE1; break;
            case 9:  g = {(const bf16_t*)(ws + WS_MG), (const bf16_t*)(ws + WS_WO), T, DM, DM}; E.mode = M_RESID; E.f0 = 1.0f; E.np = 0; E.i0 = ws + WS_XB; E.o0 = nullptr; E.o1 = ws + WS_XB; E.ssq_out = (float*)(ws + WS_SSQC); break;
            case 10: g = {XB, (const bf16_t*)(ws + WS_W2GU), T, NGU, DM}; E.mode = M_SWIGLU; E.ssq = (const float*)(ws + WS_SSQC); E.o0 = ws + WS_H; break;
            default: g = {HB, (const bf16_t*)(ws + WS_W2D), T, DM, FF}; E.mode = M_RESID; E.f0 = 0.5f; E.np = 0; E.i0 = ws + WS_XB; E.o0 = nullptr; E.o1 = ws + WS_XB; E.ssq_out = (float*)(ws + WS_SSQD); break;
            }
            pg8::StaticOrder S; S.init(g.M, g.N, (int)gridDim.x, (int)blockIdx.x);
#ifndef NO_GEMM
            pg8::gemm_phase<Epi, pg8::StaticOrder, true, true>(lds, g, S, E);
#endif
        }
      }
        if (sync_after && st + 1 < step_hi) {
            if constexpr (COOP) { xcd_barrier(gbar); }
        }
    }
}

extern "C" void kernel_launch(void* const* d_in, const int* in_sizes, int n_in, void* d_out, int out_size, void* d_ws, size_t ws_size, hipStream_t stream) {
    static int grid = 0;
    if (grid == 0) {
        if (n_in != 25 || ws_size < WS_END) { fprintf(stderr, "kernel_launch: unexpected n_in %d / ws_size %zu\n", n_in, ws_size); grid = -1; return; }
        int dev = 0, cus = 0, per_cu = 0;
        (void)hipGetDevice(&dev); (void)hipDeviceGetAttribute(&cus, hipDeviceAttributeMultiprocessorCount, dev);
        (void)hipFuncSetAttribute((const void*)fwd<N_LAUNCH_SPLIT == 0>, hipFuncAttributeMaxDynamicSharedMemorySize, LDS_BYTES);
        (void)hipOccupancyMaxActiveBlocksPerMultiprocessor(&per_cu, (const void*)fwd<N_LAUNCH_SPLIT == 0>, 512, LDS_BYTES);
        (void)hipGetLastError();
        if (per_cu < 1) per_cu = 1;
        grid = cus * 1;
        if (grid <= 0) grid = 256;
    }
    if (grid < 0) return;
    KP p{};
    p.x = (const float*)d_in[0]; p.pos = (const int*)d_in[1];
    p.n1 = (const float*)d_in[2]; p.wg1 = (const float*)d_in[3]; p.wu1 = (const float*)d_in[4]; p.wd1 = (const float*)d_in[5];
    p.nmix = (const float*)d_in[6]; p.win = (const float*)d_in[7]; p.nq = (const float*)d_in[8]; p.wuq = (const float*)d_in[9]; p.nkv = (const float*)d_in[10]; p.wukv = (const float*)d_in[11];
    p.lq1 = (const float*)d_in[12]; p.lk1 = (const float*)d_in[13]; p.lq2 = (const float*)d_in[14]; p.lk2 = (const float*)d_in[15]; p.subln = (const float*)d_in[16];
    p.pm = (const float*)d_in[17]; p.pd = (const float*)d_in[18]; p.wo = (const float*)d_in[19];
    p.n2 = (const float*)d_in[20]; p.wg2 = (const float*)d_in[21]; p.wu2 = (const float*)d_in[22]; p.wd2 = (const float*)d_in[23]; p.nfin = (const float*)d_in[24];
    p.out = (float*)d_out; p.ws = (unsigned char*)d_ws;
    for (int i = 0; i < 16; ++i) p.invf_m[i] = (float)pow(500000.0, -2.0 * i / 32.0);
    for (int i = 0; i < 8; ++i) p.invf_d[i] = (float)pow(500000.0, -2.0 * i / 16.0);
    p.scale_m = (float)(pow(96.0, -0.5) * 1.4426950408889634); p.scale_d = (float)(pow(64.0, -0.5) * 1.4426950408889634);
    const double lam_init = 0.8 - 0.6 * exp(-0.3 * 0.0);
    p.lam_init = (float)lam_init; p.one_m_lam = (float)(1.0 - lam_init);
#if N_LAUNCH_SPLIT
    const int cuts[] = {0, 1, 2, 3, 5, 8, 9, 11, 12, 13, 14, 15};
    for (int i = 0; i + 1 < (int)(sizeof(cuts) / sizeof(int)); ++i) {
        int lo = cuts[i], hi = cuts[i + 1];
        hipLaunchKernelGGL(fwd<false>, dim3(grid), dim3(512), LDS_BYTES, stream, p, lo, hi);
    }
#else
    if (hipMemsetAsync((char*)d_ws + WS_BAR, 0, BAR_BYTES, stream) != hipSuccess) { fprintf(stderr, "kernel_launch: memset of the barrier words failed\n"); return; }
    int lo = 0, hi = 15;
    void* args[] = {&p, &lo, &hi};
    hipError_t e = hipLaunchCooperativeKernel((const void*)fwd<true>, dim3(grid), dim3(512), args, LDS_BYTES, stream);
    if (e != hipSuccess) fprintf(stderr, "cooperative launch failed: %s (grid %d)\n", hipGetErrorString(e), grid);
#endif
}
```

```cpp
#include <hip/hip_runtime.h>
#include <hip/hip_cooperative_groups.h>
#include <cstdio>
#include <cstdint>
#include <cmath>
namespace cg = cooperative_groups;

namespace pg8 {
#define PG8_LAS __attribute__((address_space(3)))
typedef unsigned short bf16_t;
typedef short bf16x8 __attribute__((ext_vector_type(8)));
typedef float f32x4 __attribute__((ext_vector_type(4)));
typedef unsigned u32x4 __attribute__((ext_vector_type(4)));
constexpr int BM = 256, BK = 64, HALF = 128, HTB = HALF * BK * 2  , STAGE_BYTES = 8 * HTB, NXCD = 8, WGM = 8;

__host__ __device__ __forceinline__ int lds_byte(int r, int c) { const int st = (r >> 4) * 2 + (c >> 5), rr = r & 15, cc = c & 31, ob = rr * 64 + cc * 2; return st * 1024 + (ob ^ (((ob >> 9) & 1) << 5)); }
__host__ __device__ __forceinline__ void stage_rc(int b, int& R, int& C) { const int st = b / 1024, sb = b % 1024, swz = sb ^ (((sb >> 9) & 1) << 5); R = (st >> 1) * 16 + swz / 64; C = (st & 1) * 32 + (swz % 64) / 2; }
__host__ __device__ __forceinline__ int perm32(int rho) { const int n = rho >> 4, i = rho & 15; return 8 * (i >> 2) + 4 * n + (i & 3); }

struct Unit { int pm, pn; };
struct Gemm { const bf16_t* A; const bf16_t* Bt; int M, N, K; };

struct StaticOrder {
    int nM, nN, nwg, G, c;
    __host__ __device__ void init(int M, int N, int G_, int c_) { nM = M / BM; nN = N / BM; nwg = nM * nN; G = G_; c = c_; }
    __host__ __device__ bool next(int i, Unit& u) const {
        const long L = (long)i * G + c; if (L >= nwg) return false;
        int wgid = (int)L; { const int q = nwg / NXCD, r = nwg % NXCD, xcd = wgid % NXCD, off = wgid / NXCD; wgid = (xcd < r ? xcd * (q + 1) : r * (q + 1) + (xcd - r) * q) + off; }
        const int nig = WGM * nN, gid = wgid / nig, fm = gid * WGM, gsz = (nM - fm) < WGM ? (nM - fm) : WGM;
        u.pm = fm + ((wgid % nig) % gsz); u.pn = (wgid % nig) / gsz; return true;
    }
    __device__ __forceinline__ void a_ready(const Unit&) const {}
    __device__ __forceinline__ void done(const Unit&) const {}
};

__device__ __forceinline__ unsigned cvt_pk_bf16(float lo, float hi) { unsigned r; asm volatile("v_cvt_pk_bf16_f32 %0, %1, %2" : "=v"(r) : "v"(lo), "v"(hi)); return r; }
template <class Epi, class Sched, bool ALIGN_EPI = false, bool SP2 = false>
__device__ __forceinline__ void gemm_phase(PG8_LAS unsigned char* lds, const Gemm g, const Sched& S, const Epi& E) {
    int tid_l = threadIdx.x; asm volatile("" : "+v"(tid_l));
    const int tid = tid_l, wid = __builtin_amdgcn_readfirstlane(tid >> 6), lane = tid & 63, wr = wid >> 2, wc = wid & 3, fr = lane & 15, fq = lane >> 4;
    const int K = g.K, nt = K / BK;
    unsigned voffA[2], voffB[2];
#pragma unroll
    for (int i = 0; i < 2; ++i) { int R, C; stage_rc(tid * 16 + i * 8192, R, C); const int Rb = Epi::PERM ? ((R & ~31) + perm32(R & 31)) : R;
        voffA[i] = (unsigned)(R * K + C) * 2u; voffB[i] = (unsigned)(Rb * K + C) * 2u; }
    const size_t kstep = (size_t)(BK * 2);
    const size_t hstep = (size_t)HALF * K * 2;
    const size_t tstep = 2 * hstep;
    const unsigned ldsw = (unsigned)wid * 1024u;
    const int aoff = lds_byte(wr * 64 + fr, fq * 8), boff = lds_byte(wc * 32 + fr, fq * 8);
#define PG8_SA(b, h) (((b) * 2 + (h)) * HTB)
#define PG8_SB(b, h) ((4 + (b) * 2 + (h)) * HTB)
#define PG8_STAGE(bufoff, gbase, voff) do { _Pragma("unroll") for (int _i = 0; _i < 2; ++_i) \
        __builtin_amdgcn_global_load_lds((const unsigned*)((const char*)(gbase) + (voff)[_i]), (PG8_LAS unsigned*)(lds + (bufoff) + ldsw + _i * 8192), 16, 0, 0); } while (0)
#define PG8_LDA(dst, b, h) do { _Pragma("unroll") for (int m = 0; m < 4; ++m) _Pragma("unroll") for (int k = 0; k < 2; ++k) dst[m][k] = *(const PG8_LAS bf16x8*)(lds + PG8_SA(b, h) + aoff + m * 2048 + k * 1024); } while (0)
#define PG8_LDB(dst, b, h) do { _Pragma("unroll") for (int n = 0; n < 2; ++n) _Pragma("unroll") for (int k = 0; k < 2; ++k) dst[n][k] = *(const PG8_LAS bf16x8*)(lds + PG8_SB(b, h) + boff + n * 2048 + k * 1024); } while (0)
#define PG8_MMA(ai, bj, At, Bt) do { __builtin_amdgcn_s_setprio(1); _Pragma("unroll") for (int m = 0; m < 4; ++m) _Pragma("unroll") for (int n = 0; n < 2; ++n) _Pragma("unroll") for (int k = 0; k < 2; ++k) \
        acc[ai][bj][m][n] = __builtin_amdgcn_mfma_f32_16x16x32_bf16(Bt[n][k], At[m][k], acc[ai][bj][m][n], 0, 0, 0); __builtin_amdgcn_s_setprio(0); } while (0)
#define PG8_WAIT_V(n) asm volatile("s_waitcnt vmcnt(" #n ")" ::: "memory")
#define PG8_WAIT_L(n) asm volatile("s_waitcnt lgkmcnt(" #n ")" ::: "memory")
#define PG8_BAR __builtin_amdgcn_s_barrier()
#define PG8_SCHED __builtin_amdgcn_sched_barrier(0)
    Unit cur, nxt; int ui = 0;
    if (!S.next(0, cur)) return;
    f32x4 acc[2][2][4][2];
#pragma unroll
    for (int a = 0; a < 2; ++a)
#pragma unroll
        for (int b = 0; b < 2; ++b)
#pragma unroll
            for (int m = 0; m < 4; ++m)
#pragma unroll
                for (int n = 0; n < 2; ++n) acc[a][b][m][n] = (f32x4){0.f, 0.f, 0.f, 0.f};
    bf16x8 At[4][2], B0[2][2], B1[2][2];
    const char* cA = (const char*)g.A + (size_t)cur.pm * tstep; const char* cB = (const char*)g.Bt + (size_t)cur.pn * tstep;
    S.a_ready(cur);
    if constexpr (SP2) {
        PG8_STAGE(PG8_SB(0, 0), cB, voffB); PG8_STAGE(PG8_SB(0, 1), cB + hstep, voffB); PG8_STAGE(PG8_SA(0, 0), cA, voffA); PG8_STAGE(PG8_SA(0, 1), cA + hstep, voffA);
        if (wr == 1) PG8_BAR;
        PG8_WAIT_V(2); PG8_BAR;
        PG8_STAGE(PG8_SB(1, 0), cB + kstep, voffB); PG8_STAGE(PG8_SA(1, 0), cA + kstep, voffA); PG8_STAGE(PG8_SB(1, 1), cB + hstep + kstep, voffB);
        PG8_WAIT_V(6); PG8_BAR;
    } else {
        PG8_STAGE(PG8_SB(0, 0), cB, voffB); PG8_STAGE(PG8_SA(0, 0), cA, voffA); PG8_STAGE(PG8_SB(0, 1), cB + hstep, voffB); PG8_STAGE(PG8_SA(0, 1), cA + hstep, voffA);
        if (wr == 1) PG8_BAR;
        PG8_WAIT_V(4); PG8_BAR;
        PG8_STAGE(PG8_SB(1, 0), cB + kstep, voffB); PG8_STAGE(PG8_SA(1, 0), cA + kstep, voffA); PG8_STAGE(PG8_SB(1, 1), cB + hstep + kstep, voffB);
        PG8_WAIT_V(6); PG8_BAR;
    }
    for (;;) {
        const bool has_next = S.next(ui + 1, nxt);
        const char* nA = has_next ? (const char*)g.A + (size_t)nxt.pm * tstep : cA; const char* nB = has_next ? (const char*)g.Bt + (size_t)nxt.pn * tstep : cB;
        for (int t = 0; t < nt; t += 2) {
            if (E.mid_at == t) E.mid(acc, cur, wr, wc, fr, fq);
            const bool last = (t == nt - 2);
            const char* a1 = cA + (size_t)(t + 1) * kstep;
            const char* a2 = last ? nA : cA + (size_t)(t + 2) * kstep; const char* b2 = last ? nB : cB + (size_t)(t + 2) * kstep;
            const char* a3 = a2 + kstep; const char* b3 = b2 + kstep;
            if (last && has_next) S.a_ready(nxt);
            if constexpr (SP2) {
            PG8_LDB(B0, 0, 0); PG8_LDB(B1, 0, 1); PG8_SCHED; PG8_LDA(At, 0, 0); PG8_STAGE(PG8_SA(1, 1), a1 + hstep, voffA);
            PG8_WAIT_V(8); PG8_WAIT_L(0); PG8_BAR; PG8_MMA(0, 0, At, B0); PG8_MMA(0, 1, At, B1); PG8_BAR; PG8_SCHED;
            PG8_LDA(At, 0, 1); PG8_STAGE(PG8_SB(0, 0), b2, voffB); PG8_STAGE(PG8_SB(0, 1), b2 + hstep, voffB); PG8_STAGE(PG8_SA(0, 0), a2, voffA);
            PG8_WAIT_V(8); PG8_WAIT_L(0); PG8_BAR; PG8_MMA(1, 0, At, B0); PG8_MMA(1, 1, At, B1); PG8_BAR; PG8_SCHED;
            PG8_LDB(B0, 1, 0); PG8_LDB(B1, 1, 1); PG8_SCHED; PG8_LDA(At, 1, 0); PG8_STAGE(PG8_SA(0, 1), a2 + hstep, voffA);
            PG8_WAIT_V(8); PG8_WAIT_L(0); PG8_BAR; PG8_MMA(0, 0, At, B0); PG8_MMA(0, 1, At, B1); PG8_BAR; PG8_SCHED;
            PG8_LDA(At, 1, 1); PG8_STAGE(PG8_SB(1, 0), b3, voffB); PG8_STAGE(PG8_SB(1, 1), b3 + hstep, voffB); PG8_STAGE(PG8_SA(1, 0), a3, voffA);
            PG8_WAIT_V(8); PG8_WAIT_L(0); PG8_BAR; PG8_MMA(1, 0, At, B0); PG8_MMA(1, 1, At, B1); PG8_BAR; PG8_SCHED;
            } else {
            PG8_LDB(B0, 0, 0); PG8_SCHED; PG8_LDA(At, 0, 0); PG8_STAGE(PG8_SA(1, 1), a1 + hstep, voffA);
            PG8_WAIT_L(8); PG8_BAR; PG8_WAIT_L(0); PG8_MMA(0, 0, At, B0); PG8_BAR; PG8_SCHED;
            PG8_LDB(B1, 0, 1); PG8_STAGE(PG8_SB(0, 0), b2, voffB);
            PG8_BAR; PG8_WAIT_L(0); PG8_MMA(0, 1, At, B1); PG8_BAR;
            PG8_LDA(At, 0, 1); PG8_STAGE(PG8_SA(0, 0), a2, voffA);
            PG8_BAR; PG8_WAIT_L(0); PG8_MMA(1, 0, At, B0); PG8_BAR; PG8_SCHED;
            PG8_STAGE(PG8_SB(0, 1), b2 + hstep, voffB);
            PG8_WAIT_V(6); PG8_BAR; PG8_MMA(1, 1, At, B1); PG8_BAR;
            PG8_LDB(B0, 1, 0); PG8_SCHED; PG8_LDA(At, 1, 0); PG8_STAGE(PG8_SA(0, 1), a2 + hstep, voffA);
            PG8_WAIT_L(8); PG8_BAR; PG8_WAIT_L(0); PG8_MMA(0, 0, At, B0); PG8_BAR; PG8_SCHED;
            PG8_LDB(B1, 1, 1); PG8_STAGE(PG8_SB(1, 0), b3, voffB);
            PG8_BAR; PG8_WAIT_L(0); PG8_MMA(0, 1, At, B1); PG8_BAR;
            PG8_LDA(At, 1, 1); PG8_STAGE(PG8_SA(1, 0), a3, voffA);
            PG8_BAR; PG8_WAIT_L(0); PG8_MMA(1, 0, At, B0); PG8_BAR; PG8_SCHED;
            PG8_STAGE(PG8_SB(1, 1), b3 + hstep, voffB);
            PG8_WAIT_V(6); PG8_BAR; PG8_MMA(1, 1, At, B1); PG8_BAR;
            }
        }
        if constexpr (ALIGN_EPI) { if (wr == 0) PG8_BAR; }
        if constexpr (!Epi::AFTER_DRAIN) { E(acc, cur, wr, wc, fr, fq); S.done(cur); }
        if (!has_next) break;
#pragma unroll
        for (int a = 0; a < 2; ++a)
#pragma unroll
            for (int b = 0; b < 2; ++b)
#pragma unroll
                for (int m = 0; m < 4; ++m)
#pragma unroll
                    for (int n = 0; n < 2; ++n) acc[a][b][m][n] = (f32x4){0.f, 0.f, 0.f, 0.f};
        cur = nxt; cA = nA; cB = nB; ++ui;
        if constexpr (ALIGN_EPI) { if (wr == 1) PG8_BAR; }
    }
    PG8_WAIT_V(0);
    if constexpr (!ALIGN_EPI) { if (wr == 0) PG8_BAR; }
    PG8_BAR;
    if constexpr (Epi::AFTER_DRAIN) { E.fused(acc, cur, wr, wc, fr, fq, lds, wid, lane); S.done(cur); }
#undef PG8_SA
#undef PG8_SB
#undef PG8_STAGE
#undef PG8_LDA
#undef PG8_LDB
#undef PG8_MMA
#undef PG8_WAIT_V
#undef PG8_WAIT_L
#undef PG8_BAR
#undef PG8_SCHED
}
}

#define LAS __attribute__((address_space(3)))
typedef unsigned short bf16_t;
typedef float f32x4 __attribute__((ext_vector_type(4)));
typedef float f32x2 __attribute__((ext_vector_type(2)));
typedef float f32x16 __attribute__((ext_vector_type(16)));
typedef unsigned u32x4 __attribute__((ext_vector_type(4)));
typedef unsigned u32x2 __attribute__((ext_vector_type(2)));
typedef short bf16x8 __attribute__((ext_vector_type(8)));

constexpr int BATCH = 4, SEQ = 8192, T = BATCH * SEQ, DM = 1024, FF = 2816;
constexpr int NGU = 2 * FF;
constexpr int NWIN = 3584;
constexpr float EPS = 1e-6f;
constexpr int NUNITS = 32 * 48;
constexpr size_t MiB = 1u << 20;
constexpr size_t WS_CTL = 0, WS_BAR = 65536, BAR_BYTES = 16384;
constexpr size_t WS_SSQA = 1 * MiB, WS_SSQB = 3 * MiB, WS_SSQC = 5 * MiB, WS_SSQD = 7 * MiB, WS_SSQQ = 9 * MiB, WS_SSQKV = 9 * MiB + 512 * 1024;
constexpr size_t WS_TABM = 10 * MiB, WS_TABD = 14 * MiB;
constexpr size_t WS_W1GU = 16 * MiB, WS_W1D = 27 * MiB, WS_WIN = 33 * MiB, WS_WDV = 40 * MiB, WS_WUQ = 41 * MiB, WS_WUK = 41 * MiB + 512 * 1024, WS_WUV = 41 * MiB + 768 * 1024;
constexpr size_t WS_PM = 42 * MiB, WS_PD = 43 * MiB, WS_WO = 44 * MiB, WS_W2GU = 46 * MiB, WS_W2D = 57 * MiB;
constexpr size_t WS_XB = 64 * MiB, WS_YM = 64 * MiB, WS_YD = 96 * MiB;
constexpr size_t WS_H = 128 * MiB, WS_CQ = 128 * MiB, WS_CKV = 144 * MiB, WS_KN = 152 * MiB, WS_KR = 184 * MiB, WS_QM = 186 * MiB, WS_VTM = 234 * MiB, WS_VTD = 266 * MiB;
constexpr size_t WS_QD = 304 * MiB, WS_KD = 336 * MiB, WS_MG = 304 * MiB, WS_GM = 368 * MiB, WS_GD = 432 * MiB, WS_END = 496 * MiB;

constexpr int LDS_STAGE = 131072, LDS_BYTES = LDS_STAGE + 256;

struct KP {
    const float* x; const int* pos;
    const float *n1, *wg1, *wu1, *wd1, *nmix, *win, *nq, *wuq, *nkv, *wukv, *lq1, *lk1, *lq2, *lk2, *subln, *pm, *pd, *wo, *n2, *wg2, *wu2, *wd2, *nfin;
    float* out; unsigned char* ws;
    float invf_m[16]; float invf_d[8];
    float scale_m, scale_d, lam_init, one_m_lam;
};

typedef __bf16 bf16x2_t __attribute__((ext_vector_type(2)));
__device__ __forceinline__ unsigned cvtpk(float lo, float hi) { const f32x2 v = {lo, hi}; const bf16x2_t b = __builtin_convertvector(v, bf16x2_t); return __builtin_bit_cast(unsigned, b); }
__device__ __forceinline__ float bf_lo(unsigned w) { return __uint_as_float(w << 16); }
__device__ __forceinline__ float bf_hi(unsigned w) { return __uint_as_float(w & 0xffff0000u); }
__device__ __forceinline__ float wave_sum(float v) {
#pragma unroll
    for (int o = 1; o < 64; o <<= 1) v += __shfl_xor(v, o);
    return v;
}
__device__ __forceinline__ float sigmoidf_(float x) { return __builtin_amdgcn_rcpf(1.0f + __builtin_amdgcn_exp2f(-1.4426950408889634f * x)); }

#ifndef MODE_MASK
#define MODE_MASK 255
#endif
#define MEN(x) (((MODE_MASK) >> (x)) & 1)
enum { M_SWIGLU = 0, M_RESID = 1, M_WIN = 2, M_VT = 3, M_Q = 4, M_KN = 5, M_GATE1 = 6, M_GATE2 = 7 };
struct Epi {
    static constexpr bool PERM = true, AFTER_DRAIN = false;
    int mode, np; float inv_dim, f0;
    const float* ssq;
    const void* i0;
    void* o0; void* o1; float* ssq_out;
    unsigned char* ws; float scale; int mid_at;

    static __device__ __forceinline__ float rowsum(const float* ssq, int row, int np) {
        const f32x4* p = (const f32x4*)(ssq + (size_t)row * np);
        float s = 0.f;
        for (int i = 0; i < np / 4; ++i) { const f32x4 v = p[i]; s += (v[0] + v[1]) + (v[2] + v[3]); }
        return s;
    }
    __device__ __forceinline__ void row_scales(int rowbase, int lane, int fr, float (&rs)[2]) const {
        rs[0] = rsqrtf(rowsum(ssq, rowbase + lane, np) * inv_dim + EPS); rs[1] = rsqrtf(rowsum(ssq, rowbase + 128 + lane, np) * inv_dim + EPS);
    }
    static __device__ __forceinline__ u32x4 pack8(const f32x4 a, const f32x4 b) { u32x4 w; w.x = cvtpk(a[0], a[1]); w.y = cvtpk(a[2], a[3]); w.z = cvtpk(b[0], b[1]); w.w = cvtpk(b[2], b[3]); return w; }
    static __device__ __forceinline__ f32x4 rope4(const f32x4 v, const f32x4 cs) {
        f32x4 o; o[0] = v[0] * cs[0] - v[1] * cs[1]; o[1] = v[1] * cs[0] + v[0] * cs[1]; o[2] = v[2] * cs[2] - v[3] * cs[3]; o[3] = v[3] * cs[2] + v[2] * cs[3]; return o;
    }
    __device__ __forceinline__ void mid(f32x4 (&acc)[2][2][4][2], const pg8::Unit& u, int wr, int wc, int fr_, int fq_) const {
        int fr = fr_, fq = fq_; asm volatile("" : "+v"(fr), "+v"(fq));
        const bf16_t* gm = (const bf16_t*)(ws + WS_GM); const bf16_t* gd = (const bf16_t*)(ws + WS_GD);
        const int rowbase = u.pm * 256 + wr * 64, cw = wc * 32 + fq * 8;
#pragma unroll
        for (int ai = 0; ai < 2; ++ai)
#pragma unroll
            for (int m = 0; m < 4; ++m) {
                const int row = rowbase + ai * 128 + m * 16 + fr;
#pragma unroll
                for (int bj = 0; bj < 2; ++bj) {
                    const size_t off = (size_t)row * DM + u.pn * 256 + bj * 128 + cw;
                    const u32x4 a = *(const u32x4*)(gm + off), b = *(const u32x4*)(gd + off);
                    f32x4 r0, r1;
                    r0[0] = bf_lo(a.x) * __builtin_amdgcn_rcpf(fmaxf(bf_lo(b.x), 1e-30f)); r0[1] = bf_hi(a.x) * __builtin_amdgcn_rcpf(fmaxf(bf_hi(b.x), 1e-30f));
                    r0[2] = bf_lo(a.y) * __builtin_amdgcn_rcpf(fmaxf(bf_lo(b.y), 1e-30f)); r0[3] = bf_hi(a.y) * __builtin_amdgcn_rcpf(fmaxf(bf_hi(b.y), 1e-30f));
                    r1[0] = bf_lo(a.z) * __builtin_amdgcn_rcpf(fmaxf(bf_lo(b.z), 1e-30f)); r1[1] = bf_hi(a.z) * __builtin_amdgcn_rcpf(fmaxf(bf_hi(b.z), 1e-30f));
                    r1[2] = bf_lo(a.w) * __builtin_amdgcn_rcpf(fmaxf(bf_lo(b.w), 1e-30f)); r1[3] = bf_hi(a.w) * __builtin_amdgcn_rcpf(fmaxf(bf_hi(b.w), 1e-30f));
                    acc[ai][bj][m][0] *= r0; acc[ai][bj][m][1] *= r1;
                }
            }
    }
    __device__ __forceinline__ void operator()(const f32x4 (&acc)[2][2][4][2], const pg8::Unit& u, int wr, int wc, int fr_, int fq_) const {
        int fr = fr_, fq = fq_; asm volatile("" : "+v"(fr), "+v"(fq));
        const int lane = fr + 16 * fq;
        const int rowbase = u.pm * 256 + wr * 64;
        const int cw = wc * 32 + fq * 8;
        if (MEN(0) && mode == M_SWIGLU) {
            float rs[2]; row_scales(rowbase, lane, fr, rs);
            bf16_t* H = (bf16_t*)o0;
#pragma unroll
            for (int ai = 0; ai < 2; ++ai)
#pragma unroll
                for (int m = 0; m < 4; ++m) {
                    const int row = rowbase + ai * 128 + m * 16 + fr; const float r = __shfl(rs[ai], m * 16 + fr);
                    f32x4 h[2];
                    const float cr = -1.4426950408889634f * r, r2 = r * r;
#pragma unroll
                    for (int n = 0; n < 2; ++n) { const f32x4 g = acc[ai][0][m][n], up = acc[ai][1][m][n];
#pragma unroll
                        for (int j = 0; j < 4; ++j) h[n][j] = (g[j] * up[j]) * (r2 * __builtin_amdgcn_rcpf(1.0f + __builtin_amdgcn_exp2f(g[j] * cr))); }
                    *(u32x4*)(H + (size_t)row * FF + u.pn * 128 + cw) = pack8(h[0], h[1]);
                }
        } else if (MEN(1) && mode == M_RESID) {
            const float* res = (const float*)i0; const bf16_t* resb = (const bf16_t*)i0; float* outp = (float*)o0; bf16_t* xb = (bf16_t*)o1; const bool rb16 = np == 0;
#pragma unroll
            for (int ai = 0; ai < 2; ++ai)
#pragma unroll
                for (int m = 0; m < 4; ++m) {
                    const int row = rowbase + ai * 128 + m * 16 + fr; float s = 0.f;
#pragma unroll
                    for (int bj = 0; bj < 2; ++bj) {
                        const size_t off = (size_t)row * DM + u.pn * 256 + bj * 128 + cw;
                        f32x4 a, b;
                        if (rb16) { const u32x4 w = *(const u32x4*)(resb + off); a = (f32x4){bf_lo(w.x), bf_hi(w.x), bf_lo(w.y), bf_hi(w.y)}; b = (f32x4){bf_lo(w.z), bf_hi(w.z), bf_lo(w.w), bf_hi(w.w)}; }
                        else { a = *(const f32x4*)(res + off); b = *(const f32x4*)(res + off + 4); }
                        const f32x4 v0 = a + acc[ai][bj][m][0] * f0, v1 = b + acc[ai][bj][m][1] * f0;
                        if (outp) { *(f32x4*)(outp + off) = v0; *(f32x4*)(outp + off + 4) = v1; }
                        if (xb) *(u32x4*)(xb + off) = pack8(v0, v1);
                        s += (v0[0] * v0[0] + v0[1] * v0[1]) + (v0[2] * v0[2] + v0[3] * v0[3]) + (v1[0] * v1[0] + v1[1] * v1[1]) + (v1[2] * v1[2] + v1[3] * v1[3]);
                    }
                    s += __shfl_xor(s, 16); s += __shfl_xor(s, 32);
                    if (fq == 0) ssq_out[(size_t)row * 16 + u.pn * 4 + wc] = s;
                }
        } else if (MEN(2) && mode == M_WIN) {
            float rs[2]; row_scales(rowbase, lane, fr, rs);
            const int pn = u.pn;
            bf16_t* cq = (bf16_t*)(ws + WS_CQ); bf16_t* ckv = (bf16_t*)(ws + WS_CKV); bf16_t* kr = (bf16_t*)(ws + WS_KR); bf16_t* qd = (bf16_t*)(ws + WS_QD); bf16_t* kd = (bf16_t*)(ws + WS_KD);
            bf16_t* gm = (bf16_t*)(ws + WS_GM); bf16_t* gd = (bf16_t*)(ws + WS_GD); float* ssq_q = (float*)(ws + WS_SSQQ); float* ssq_kv = (float*)(ws + WS_SSQKV);
            const f32x4* tabm = (const f32x4*)(ws + WS_TABM); const f32x4* tabd = (const f32x4*)(ws + WS_TABD);
#pragma unroll
            for (int ai = 0; ai < 2; ++ai)
#pragma unroll
                for (int m = 0; m < 4; ++m) {
                    const int row = rowbase + ai * 128 + m * 16 + fr; const float r = __shfl(rs[ai], m * 16 + fr);
                    f32x4 v[2][2];
#pragma unroll
                    for (int bj = 0; bj < 2; ++bj) { v[bj][0] = acc[ai][bj][m][0] * r; v[bj][1] = acc[ai][bj][m][1] * r; }
                    if (pn == 0) {
                        float s = 0.f;
#pragma unroll
                        for (int bj = 0; bj < 2; ++bj) {
                            *(u32x4*)(cq + (size_t)row * 256 + bj * 128 + cw) = pack8(v[bj][0], v[bj][1]);
#pragma unroll
                            for (int n = 0; n < 2; ++n) s += (v[bj][n][0] * v[bj][n][0] + v[bj][n][1] * v[bj][n][1]) + (v[bj][n][2] * v[bj][n][2] + v[bj][n][3] * v[bj][n][3]);
                        }
                        s += __shfl_xor(s, 16); s += __shfl_xor(s, 32);
                        if (fq == 0) ssq_q[(size_t)row * 4 + wc] = s;
                    } else if (pn == 1) {
                        float s = 0.f;
                        *(u32x4*)(ckv + (size_t)row * 128 + cw) = pack8(v[0][0], v[0][1]);
#pragma unroll
                        for (int n = 0; n < 2; ++n) s += (v[0][n][0] * v[0][n][0] + v[0][n][1] * v[0][n][1]) + (v[0][n][2] * v[0][n][2] + v[0][n][3] * v[0][n][3]);
                        s += __shfl_xor(s, 16); s += __shfl_xor(s, 32);
                        if (fq == 0) ssq_kv[(size_t)row * 4 + wc] = s;
                        if (wc == 0) {
                            const f32x4 c0 = tabm[(size_t)row * 8 + 2 * fq], c1 = tabm[(size_t)row * 8 + 2 * fq + 1];
                            *(u32x4*)(kr + (size_t)row * 32 + fq * 8) = pack8(rope4(v[1][0], c0), rope4(v[1][1], c1));
                        }
                    } else if (pn < 6) {
                        const bool isq = pn < 4; bf16_t* base = isq ? qd : kd; const int coff = (pn - (isq ? 2 : 4)) * 256; const float sc = isq ? scale : 1.0f;
                        const bool rp = ((wc & 1) == 0) && (fq < 2);
                        f32x4 c0 = (f32x4){1.f, 0.f, 1.f, 0.f}, c1 = c0;
                        if (rp) { c0 = tabd[(size_t)row * 4 + 2 * fq]; c1 = tabd[(size_t)row * 4 + 2 * fq + 1]; }
#pragma unroll
                        for (int bj = 0; bj < 2; ++bj)
                            *(u32x4*)(base + (size_t)row * 512 + coff + bj * 128 + cw) = pack8(rope4(v[bj][0], c0) * sc, rope4(v[bj][1], c1) * sc);
                    } else {
                        const bool ism = pn < 10; bf16_t* base = ism ? gm : gd; const int coff = (pn - (ism ? 6 : 10)) * 256;
#pragma unroll
                        for (int bj = 0; bj < 2; ++bj) {
                            f32x4 a, b;
#pragma unroll
                            for (int j = 0; j < 4; ++j) { a[j] = sigmoidf_(v[bj][0][j]); b[j] = sigmoidf_(v[bj][1][j]); }
                            *(u32x4*)(base + (size_t)row * DM + coff + bj * 128 + cw) = pack8(a, b);
                        }
                    }
                }
        } else if (MEN(3) && mode == M_VT) {
            bf16_t* vt = (bf16_t*)o0;
            float cs[2][2][4];
            {
                const int tok = u.pn * 256 + (lane >> 5) * 128 + wc * 32 + (lane & 31);
                const float r = rsqrtf(rowsum(ssq, tok, np) * inv_dim + EPS);
#pragma unroll
                for (int bj = 0; bj < 2; ++bj)
#pragma unroll
                    for (int n = 0; n < 2; ++n)
#pragma unroll
                        for (int j = 0; j < 4; ++j) cs[bj][n][j] = __shfl(r, bj * 32 + fq * 8 + n * 4 + j);
            }
#pragma unroll
            for (int ai = 0; ai < 2; ++ai)
#pragma unroll
                for (int m = 0; m < 4; ++m) {
                    const int f = rowbase + ai * 128 + m * 16 + fr;
#pragma unroll
                    for (int bj = 0; bj < 2; ++bj)
#pragma unroll
                        for (int n = 0; n < 2; ++n) {
                            const f32x4 a = acc[ai][bj][m][n];
                            u32x2 w; w.x = cvtpk(a[0] * cs[bj][n][0], a[1] * cs[bj][n][1]); w.y = cvtpk(a[2] * cs[bj][n][2], a[3] * cs[bj][n][3]);
                            { const int tok = u.pn * 256 + bj * 128 + wc * 32 + (fq >> 1) * 16 + n * 8 + (fq & 1) * 4; *(u32x2*)(vt + ((size_t)(tok >> 6) * 512 + f) * 64 + (tok & 63)) = w; }
                        }
                }
        } else if (MEN(4) && mode == M_Q) {
            float rs[2]; row_scales(rowbase, lane, fr, rs);
            bf16_t* qm = (bf16_t*)o0; const f32x4* tabm = (const f32x4*)(ws + WS_TABM);
#pragma unroll
            for (int ai = 0; ai < 2; ++ai)
#pragma unroll
                for (int m = 0; m < 4; ++m) {
                    const int row = rowbase + ai * 128 + m * 16 + fr; const float r = __shfl(rs[ai], m * 16 + fr) * scale;
                    const f32x4 c0 = tabm[(size_t)row * 8 + 2 * fq], c1 = tabm[(size_t)row * 8 + 2 * fq + 1];
#pragma unroll
                    for (int bj = 0; bj < 2; ++bj) {
                        const int sl = u.pn * 8 + bj * 4 + wc;
                        f32x4 a = acc[ai][bj][m][0] * r, b = acc[ai][bj][m][1] * r;
                        if (sl % 3 == 2) { a = rope4(a, c0); b = rope4(b, c1); }
                        *(u32x4*)(qm + (size_t)row * 768 + u.pn * 256 + bj * 128 + cw) = pack8(a, b);
                    }
                }
        } else if (MEN(5) && mode == M_KN) {
            float rs[2]; row_scales(rowbase, lane, fr, rs);
            bf16_t* kn = (bf16_t*)o0;
#pragma unroll
            for (int ai = 0; ai < 2; ++ai)
#pragma unroll
                for (int m = 0; m < 4; ++m) {
                    const int row = rowbase + ai * 128 + m * 16 + fr; const float r = __shfl(rs[ai], m * 16 + fr);
#pragma unroll
                    for (int bj = 0; bj < 2; ++bj)
                        *(u32x4*)(kn + (size_t)row * 512 + u.pn * 256 + bj * 128 + cw) = pack8(acc[ai][bj][m][0] * r, acc[ai][bj][m][1] * r);
                }
        } else if (MEN(6)) {
            const bf16_t* G = (const bf16_t*)i0; bf16_t* mg = (bf16_t*)o0;
#pragma unroll
            for (int ai = 0; ai < 2; ++ai)
#pragma unroll
                for (int m = 0; m < 4; ++m) {
                    const int row = rowbase + ai * 128 + m * 16 + fr;
#pragma unroll
                    for (int bj = 0; bj < 2; ++bj) {
                        const size_t off = (size_t)row * DM + u.pn * 256 + bj * 128 + cw;
                        const u32x4 g = *(const u32x4*)(G + off);
                        f32x4 a = acc[ai][bj][m][0], b = acc[ai][bj][m][1];
                        a[0] *= fmaxf(bf_lo(g.x), 1e-30f); a[1] *= fmaxf(bf_hi(g.x), 1e-30f); a[2] *= fmaxf(bf_lo(g.y), 1e-30f); a[3] *= fmaxf(bf_hi(g.y), 1e-30f);
                        b[0] *= fmaxf(bf_lo(g.z), 1e-30f); b[1] *= fmaxf(bf_hi(g.z), 1e-30f); b[2] *= fmaxf(bf_lo(g.w), 1e-30f); b[3] *= fmaxf(bf_hi(g.w), 1e-30f);
                        if (mode == M_GATE2) {
                            const u32x4 p = *(const u32x4*)(mg + off);
                            a[0] += bf_lo(p.x); a[1] += bf_hi(p.x); a[2] += bf_lo(p.y); a[3] += bf_hi(p.y);
                            b[0] += bf_lo(p.z); b[1] += bf_hi(p.z); b[2] += bf_lo(p.w); b[3] += bf_hi(p.w);
                        }
                        *(u32x4*)(mg + off) = pack8(a, b);
                    }
                }
        }
    }
};

template <class SrcFn>
__device__ __forceinline__ void cvt_item(SrcFn src, int sstride, const float* gain, int K, bf16_t* WT, LAS float* scr, int item, int nblk, int lane) {
    const int kb = item / nblk, nb = item % nblk, k0 = 64 * kb, n0 = 32 * nb;
    const float* sp = src(n0 + (lane & 31));
    float vv[32];
#pragma unroll
    for (int i = 0; i < 32; ++i) { const int kk = 2 * i + (lane >> 5); vv[i] = sp ? sp[(size_t)(k0 + kk) * sstride] : 0.f; }
    if (gain) {
#pragma unroll
        for (int i = 0; i < 32; ++i) vv[i] *= gain[k0 + 2 * i + (lane >> 5)];
    }
#pragma unroll
    for (int i = 0; i < 32; ++i) scr[(2 * i + (lane >> 5)) * 33 + (lane & 31)] = vv[i];
    asm volatile("s_waitcnt lgkmcnt(0)" ::: "memory");
    const int c = lane & 7;
#pragma unroll
    for (int j = 0; j < 4; ++j) { const int n = (lane >> 3) + 8 * j; const LAS float* s = scr + (8 * c) * 33 + n;
        u32x4 o; o.x = cvtpk(s[0 * 33], s[1 * 33]); o.y = cvtpk(s[2 * 33], s[3 * 33]); o.z = cvtpk(s[4 * 33], s[5 * 33]); o.w = cvtpk(s[6 * 33], s[7 * 33]);
        *(u32x4*)(WT + (size_t)(n0 + n) * K + k0 + 8 * c) = o; }
    asm volatile("s_waitcnt lgkmcnt(0)" ::: "memory");
}

__device__ __forceinline__ void prologue(const KP& p, LAS unsigned char* lds, unsigned char* ws) {
    int tid_l = threadIdx.x; asm volatile("" : "+v"(tid_l));
    const int tid = tid_l, lane = tid & 63, wave = tid >> 6;
    const int gw = blockIdx.x * 8 + wave, NGW = gridDim.x * 8;
    if (blockIdx.x == 0 && tid < 32) ((unsigned*)(ws + WS_CTL))[tid * 64] = 0u;
    if (blockIdx.x == 1 && tid < 192) {
        const int qb = tid / 6, sl = tid % 6; const float c = sl < 2 ? 2.4f * (qb + 1) + 0.5f : (float)(qb + 1);
        int rank = 0;
        for (int j = 0; j < 192; ++j) { const int qj = j / 6, sj = j % 6; const float cj = sj < 2 ? 2.4f * (qj + 1) + 0.5f : (float)(qj + 1); rank += (cj > c || (cj == c && j < tid)) ? 1 : 0; }
        ((int*)(ws + WS_CTL + 32768))[rank] = qb * 8 + sl;
    }
    LAS float* scr = (LAS float*)(lds + wave * 16384);
    constexpr int I_GU = (DM / 64) * (NGU / 32), I_D = (FF / 64) * (DM / 32), I_WIN = (DM / 64) * (NWIN / 32), I_DV = (DM / 64) * (512 / 32), I_UQ = (256 / 64) * (768 / 32),
                  I_UK = (128 / 64) * (512 / 32), I_P = (512 / 64) * (DM / 32), I_O = (DM / 64) * (DM / 32);
    constexpr int NIT = 2 * I_GU + 2 * I_D + I_WIN + I_DV + I_UQ + 2 * I_UK + 2 * I_P + I_O;
    for (int it = gw; it < NIT; it += NGW) {
        int r = it, mat, K, nblk, sstride; const float* gain = nullptr; const float* w0; const float* w1 = nullptr; size_t dst;
        if (r < 2 * I_GU) { const bool sec = r >= I_GU; if (sec) r -= I_GU; mat = 0; K = DM; nblk = NGU / 32; sstride = FF; gain = sec ? p.n2 : p.n1; w0 = sec ? p.wg2 : p.wg1; w1 = sec ? p.wu2 : p.wu1; dst = sec ? WS_W2GU : WS_W1GU; }
        else if ((r -= 2 * I_GU) < 2 * I_D) { const bool sec = r >= I_D; if (sec) r -= I_D; mat = 1; K = FF; nblk = DM / 32; sstride = DM; w0 = sec ? p.wd2 : p.wd1; dst = sec ? WS_W2D : WS_W1D; }
        else if ((r -= 2 * I_D) < I_WIN) { mat = 2; K = DM; nblk = NWIN / 32; sstride = 4000; gain = p.nmix; w0 = p.win; dst = WS_WIN; }
        else if ((r -= I_WIN) < I_DV) { mat = 1; K = DM; nblk = 512 / 32; sstride = 4000; gain = p.nmix; w0 = p.win + 1440; dst = WS_WDV; }
        else if ((r -= I_DV) < I_UQ) { mat = 3; K = 256; nblk = 768 / 32; sstride = 768; gain = p.nq; w0 = p.wuq; dst = WS_WUQ; }
        else if ((r -= I_UQ) < 2 * I_UK) { const bool isv = r >= I_UK; if (isv) r -= I_UK; mat = 4; K = 128; nblk = 512 / 32; sstride = 1024; gain = p.nkv; w0 = p.wukv + (isv ? 64 : 0); dst = isv ? WS_WUV : WS_WUK; }
        else if ((r -= 2 * I_UK) < 2 * I_P) { const bool sec = (r / (DM / 32)) >= 8; mat = 1; K = 1024; nblk = DM / 32; sstride = DM; w0 = sec ? p.pd - (size_t)512 * DM : p.pm; dst = WS_PM; }
        else { r -= 2 * I_P; mat = 1; K = DM; nblk = DM / 32; sstride = DM; w0 = p.wo; dst = WS_WO; }
        cvt_item([=](int n) -> const float* {
                     if (mat == 0) { const int t = n >> 8, w = n & 255; return w < 128 ? w0 + t * 128 + w : w1 + t * 128 + (w - 128); }
                     if (mat == 1) return w0 + n;
                     if (mat == 2) {
                         if (n < 384) return w0 + n;
                         if (n < 416) { const int q = n - 384; return w0 + 384 + (q & 1) * 16 + (q >> 1); }
                         if (n < 512) return nullptr;
                         if (n < 1536) { const int c = n - 512, base = c < 512 ? 416 : 928, cc = c & 511, h = cc >> 6, ww = cc & 63; const int sw = ww < 16 ? (ww & 1) * 8 + (ww >> 1) : ww; return w0 + base + h * 64 + sw; }
                         if (n < 2560) return w0 + 1952 + (n - 1536);
                         return w0 + 2976 + (n - 2560);
                     }
                     if (mat == 3) { const int h = n / 96, ww = n % 96; if (ww < 64) return w0 + h * 96 + ww; const int q = ww - 64; return w0 + h * 96 + 64 + (q & 1) * 16 + (q >> 1); }
                     return w0 + (n >> 6) * 128 + (n & 63); },
                 sstride, gain, K, (bf16_t*)(ws + dst), scr, r, nblk, lane);
    }
    bf16_t* xb = (bf16_t*)(ws + WS_XB); float* ssqa = (float*)(ws + WS_SSQA);
    for (int m = gw; m < T; m += NGW) {
        const f32x4* xr = (const f32x4*)(p.x + (size_t)m * DM) + lane;
        f32x4 v[4]; float s = 0.f;
#pragma unroll
        for (int j = 0; j < 4; ++j) { v[j] = xr[64 * j]; s += (v[j][0] * v[j][0] + v[j][1] * v[j][1]) + (v[j][2] * v[j][2] + v[j][3] * v[j][3]); }
        s = wave_sum(s);
        u32x2* o8 = (u32x2*)(xb + (size_t)m * DM) + lane;
#pragma unroll
        for (int j = 0; j < 4; ++j) { u32x2 w; w.x = cvtpk(v[j][0], v[j][1]); w.y = cvtpk(v[j][2], v[j][3]); o8[64 * j] = w; }
        if (lane < 16) ssqa[(size_t)m * 16 + lane] = lane == 0 ? s : 0.f;
    }
    f32x2* tabm = (f32x2*)(ws + WS_TABM); f32x2* tabd = (f32x2*)(ws + WS_TABD);
    for (int idx = blockIdx.x * 512 + tid; idx < T * 24; idx += gridDim.x * 512) {
        const int t = idx / 24, i = idx % 24;
        const float invf = i < 16 ? p.invf_m[i] : p.invf_d[i - 16];
        const double rev = (double)p.pos[t] * (double)invf * 0.15915494309189535;
        const float fr = (float)(rev - rint(rev));
        const f32x2 cs = (f32x2){__builtin_amdgcn_cosf(fr), __builtin_amdgcn_sinf(fr)};
        if (i < 16) tabm[(size_t)t * 16 + i] = cs; else tabd[(size_t)t * 8 + (i - 16)] = cs;
    }
}

__device__ __forceinline__ int crow(int r, int hi) { return (r & 3) + 8 * (r >> 2) + 4 * hi; }
#define GAS __attribute__((address_space(1)))
#define GLD16(p) (*(const GAS u32x4*)(p))
#define MFMA32(a, b, c) __builtin_amdgcn_mfma_f32_32x32x16_bf16((a), (b), (c), 0, 0, 0)

__device__ __forceinline__ float max3f(float a, float b, float c) { float r; asm("v_max3_f32 %0, %1, %2, %3" : "=v"(r) : "v"(a), "v"(b), "v"(c)); return r; }
__device__ __forceinline__ float max2f(float a, float b) { float r; asm("v_max_f32_e32 %0, %1, %2" : "=v"(r) : "v"(a), "v"(b)); return r; }
__device__ __forceinline__ float xhalf_max(float v) { auto rr = __builtin_amdgcn_permlane32_swap(__float_as_uint(v), __float_as_uint(v), false, false); return __builtin_fmaxf(__uint_as_float(rr[0]), __uint_as_float(rr[1])); }
__device__ __forceinline__ float xhalf_sum(float v) { auto rr = __builtin_amdgcn_permlane32_swap(__float_as_uint(v), __float_as_uint(v), false, false); return __uint_as_float(rr[0]) + __uint_as_float(rr[1]); }

__device__ __forceinline__ void glds16(const void* gsrc, unsigned lds_dst) {
    unsigned keep;
    asm volatile("s_mov_b32 %0, m0\n\ts_mov_b32 m0, %2\n\ts_nop 0\n\tglobal_load_lds_dwordx4 %1, off\n\ts_mov_b32 m0, %0" : "=&s"(keep) : "v"(gsrc), "s"(lds_dst) : "memory");
}
template <int DQK, int DV, bool MLA>
__device__ __forceinline__ void attn_pass(LAS unsigned char* lds, const bf16_t* Qrow, const bf16_t* K0, int pitchK, const bf16_t* KrB, const bf16_t* Vt0, int NT, int q0w,
                                          f32x16 (&o)[DV / 32], float& l_out, int tid) {
    constexpr int KB = 8192, KRB = 4096, VB = DV * 128, NVC = DV / 64, ND = DQK / 16, NDV = DV / 32;
    constexpr int KROFF = 4 * KB, VOFF = 4 * KB + (MLA ? 4 * KRB : 0);
    constexpr int NP = 1 + NVC + (MLA ? 1 : 0);
    constexpr int NG = 4 * NDV, EPG = 32 / NG;
    constexpr float THR = 8.0f;
    static_assert(NP == 3, "the counted waits below assume three pieces per wave per tile");
    const int lane = tid & 63, r32 = lane & 31, hi = lane >> 5;
    const int wid = __builtin_amdgcn_readfirstlane(tid >> 6);
    const unsigned lds0 = (unsigned)(uintptr_t)lds;
    bf16x8 q[ND];
#pragma unroll
    for (int d0 = 0; d0 < ND; ++d0) q[d0] = *(const GAS bf16x8*)(Qrow + 16 * d0 + 8 * hi);
#pragma unroll
    for (int d = 0; d < NDV; ++d)
#pragma unroll
        for (int r = 0; r < 16; ++r) o[d][r] = 0.f;
    float m = 0.f, l = 0.f;
    f32x16 negm;
#pragma unroll
    for (int r = 0; r < 16; ++r) negm[r] = 0.f;
#pragma unroll
    for (int d0 = 0; d0 < ND; ++d0) asm volatile("" : "+v"(q[d0]));
    const bf16_t* ksrc; const bf16_t* rsrc = nullptr; const bf16_t* vsrc[NVC];
    { const int row = 8 * wid + (lane >> 3), c = (lane & 7) ^ ((row >> 1) & 7); ksrc = K0 + (size_t)row * pitchK + c * 8; }
    if (MLA) { const int row = 16 * (wid & 3) + (lane >> 2), c = (lane & 3) ^ ((row >> 2) & 3); rsrc = KrB + (size_t)row * 32 + c * 8; }
#pragma unroll
    for (int j = 0; j < NVC; ++j) { const int row = 8 * (wid + 8 * j) + (lane >> 3), c = (lane & 7) ^ ((row >> 1) & 7); vsrc[j] = Vt0 + (size_t)row * 64 + c * 8; }
#define ATT_DMA_K(tt, kslot) do { \
        glds16(ksrc + (size_t)(tt) * 64 * pitchK, (unsigned)__builtin_amdgcn_readfirstlane(lds0 + (kslot) * KB + wid * 1024)); \
        if (MLA) glds16(rsrc + (size_t)(tt) * 64 * 32, (unsigned)__builtin_amdgcn_readfirstlane(lds0 + KROFF + (kslot) * KRB + (wid & 3) * 1024)); } while (0)
#define ATT_DMA_V(tt, vslot) do { \
        _Pragma("unroll") for (int j = 0; j < NVC; ++j) glds16(vsrc[j] + (size_t)(tt) * (512 * 64), (unsigned)__builtin_amdgcn_readfirstlane(lds0 + VOFF + (vslot) * VB + (wid + 8 * j) * 1024)); } while (0)
    const int xs = (r32 >> 1) & 7;
    const int yk = (xs ^ hi) << 4;
    const int yr = (((r32 >> 2) & 3) ^ hi) << 4;
    bf16x8 kf[2 * ND];
#define ATT_KLOAD(kslot) do { \
        const LAS unsigned char* kp_ = lds + (kslot) * KB + r32 * 128; \
        _Pragma("unroll") for (int d0 = 0; d0 < ND; ++d0) { \
            if (MLA && d0 >= 4) { const LAS unsigned char* rp_ = lds + KROFF + (kslot) * KRB + r32 * 64 + ((32 * (d0 - 4)) ^ yr); kf[2 * d0] = *(const LAS bf16x8*)rp_; kf[2 * d0 + 1] = *(const LAS bf16x8*)(rp_ + 32 * 64); } \
            else { kf[2 * d0] = *(const LAS bf16x8*)(kp_ + ((32 * d0) ^ yk)); kf[2 * d0 + 1] = *(const LAS bf16x8*)(kp_ + 32 * 128 + ((32 * d0) ^ yk)); } } } while (0)
    ATT_DMA_K(0, 0); ATT_DMA_V(0, 0); ATT_DMA_K(1, 1); ATT_DMA_V(1, 1); ATT_DMA_K(2, 2);
    asm volatile("s_waitcnt vmcnt(0)" ::: "memory");
    __builtin_amdgcn_s_barrier();
    asm volatile("" ::: "memory");
    ATT_KLOAD(0);
    bf16x8 pf[4];
    bool pend = false;
    int vs_prev = 0;
#define PV_D(g) (NDV == 4 ? (((g) & 1) + 2 * ((g) >> 3)) : ((g) & 1))
#define PV_KS(g) (((g) >> 1) & 3)
#define PV_IDX(g) (((g) & 1) * 4 + PV_KS(g))
#define VFRAG(vp, d, ks) (*(const LAS bf16x8*)((vp) + (32 * (d)) * 128 + ((32 * (ks)) ^ yk)))
    for (int t = 0; t < NT; ++t) {
        const bool far = t + 3 < NT;
        if (far) ATT_DMA_K(t + 3, (t + 3) & 3);
        if (t + 2 < NT) ATT_DMA_V(t + 2, (t + 2) & 3);
        const LAS unsigned char* vp = lds + VOFF + vs_prev * VB + r32 * 128;
        if (64 * t <= q0w + 31) {
            f32x16 s0, s1;
            if constexpr (MLA) { s0 = negm; s1 = negm; }
            else {
#pragma unroll
                for (int r = 0; r < 16; ++r) { s0[r] = 0.f; s1[r] = 0.f; }
            }
            __builtin_amdgcn_s_setprio(1);
#pragma unroll
            for (int d0 = 0; d0 < ND; ++d0) { s0 = MFMA32(kf[2 * d0], q[d0], s0); s1 = MFMA32(kf[2 * d0 + 1], q[d0], s1); }
            __builtin_amdgcn_s_setprio(0);
            __builtin_amdgcn_sched_barrier(0);
            if (t + 1 < NT) ATT_KLOAD((t + 1) & 3);
            bf16x8 vf[8];
            if (pend) {
#pragma unroll
                for (int g = 0; g < 8; ++g) vf[PV_IDX(g)] = VFRAG(vp, PV_D(g), PV_KS(g));
            }
            __builtin_amdgcn_sched_barrier(0);
            if (64 * t + 63 > q0w) {
                int hi_l = hi; asm volatile("" : "+v"(hi_l));
                const int qrow = q0w + r32, kb0 = 64 * t + 4 * hi_l;
#pragma unroll
                for (int r = 0; r < 16; ++r) { const int kv = kb0 + (r & 3) + 8 * (r >> 2); if (kv > qrow) s0[r] = -INFINITY; if (kv + 32 > qrow) s1[r] = -INFINITY; }
            }
            float mx;
            asm volatile("s_nop 11" : "+v"(s0), "+v"(s1));
            {
                float a = max3f(s0[0], s0[1], s1[0]), b = max3f(s0[2], s0[3], s1[1]); a = max3f(a, s1[2], s1[3]);
#pragma unroll
                for (int r = 4; r < 16; r += 4) { a = max3f(a, s0[r], s0[r + 1]); b = max3f(b, s0[r + 2], s0[r + 3]); a = max3f(a, s1[r], s1[r + 1]); b = max3f(b, s1[r + 2], s1[r + 3]); }
                mx = xhalf_max(__builtin_fmaxf(a, b)) - (MLA ? 0.f : m);
            }
            if (t == 0 || __any(mx > THR)) {
                if (pend) {
#pragma unroll
                    for (int g = 0; g < NG; ++g) {
                        o[PV_D(g)] = MFMA32(vf[PV_IDX(g)], pf[PV_KS(g)], o[PV_D(g)]);
                        if (NDV == 4 && g < 8) vf[PV_IDX(g)] = VFRAG(vp, PV_D(g) + 2, PV_KS(g));
                    }
                    pend = false;
                }
                const float dl = t == 0 ? mx : fmaxf(mx, 0.f);
                m += dl;
                if constexpr (MLA) {
#pragma unroll
                    for (int r = 0; r < 16; ++r) { s0[r] -= dl; s1[r] -= dl; negm[r] = -m; }
                }
                const float a = __builtin_amdgcn_exp2f(-dl);
                l *= a;
#pragma unroll
                for (int d = 0; d < NDV; ++d)
#pragma unroll
                    for (int r = 0; r < 16; ++r) o[d][r] *= a;
            }
            float ps = 0.f;
            u32x4 pw[4];
            float ps1 = 0.f;
            if (pend) {
#pragma unroll
                for (int g = 0; g <= NG; ++g) {
                    if (g < NG) {
                        o[PV_D(g)] = MFMA32(vf[PV_IDX(g)], pf[PV_KS(g)], o[PV_D(g)]);
                        if (NDV == 4 && g < 8) vf[PV_IDX(g)] = VFRAG(vp, PV_D(g) + 2, PV_KS(g));
#pragma unroll
                        for (int e = g * EPG; e < (g + 1) * EPG; ++e) { if (e < 16) s0[e] = __builtin_amdgcn_exp2f(MLA ? s0[e] : s0[e] - m); else s1[e - 16] = __builtin_amdgcn_exp2f(MLA ? s1[e - 16] : s1[e - 16] - m); }
                    }
                    if (g > 0) {
#pragma unroll
                        for (int e = (g - 1) * EPG; e < g * EPG; ++e) {
                            const float v = e < 16 ? s0[e] : s1[e - 16];
                            if (e & 1) ps1 += v; else ps += v;
                            if (e & 1) { const int j = e >> 1; pw[j >> 2][j & 3] = e < 16 ? cvtpk(s0[e - 1], s0[e]) : cvtpk(s1[e - 17], s1[e - 16]); }
                        }
                    }
                    __builtin_amdgcn_sched_barrier(0);
                }
            } else {
                float m2 = MLA ? 0.f : m; asm volatile("" : "+v"(m2));
#pragma unroll
                for (int e = 0; e < 32; ++e) {
                    if (e < 16) { s0[e] = __builtin_amdgcn_exp2f(MLA ? s0[e] + m2 : s0[e] - m2); ps += s0[e]; } else { s1[e - 16] = __builtin_amdgcn_exp2f(MLA ? s1[e - 16] + m2 : s1[e - 16] - m2); ps += s1[e - 16]; }
                    if (e & 1) { const int j = e >> 1; pw[j >> 2][j & 3] = e < 16 ? cvtpk(s0[e - 1], s0[e]) : cvtpk(s1[e - 17], s1[e - 16]); }
                }
            }
            l += ps + ps1;
#pragma unroll
            for (int k = 0; k < 4; ++k) pf[k] = __builtin_bit_cast(bf16x8, pw[k]);
            pend = true;
        } else if (pend) {
            bf16x8 vf[8];
#pragma unroll
            for (int g = 0; g < 8; ++g) vf[PV_IDX(g)] = VFRAG(vp, PV_D(g), PV_KS(g));
#pragma unroll
            for (int g = 0; g < NG; ++g) {
                o[PV_D(g)] = MFMA32(vf[PV_IDX(g)], pf[PV_KS(g)], o[PV_D(g)]);
                if (NDV == 4 && g < 8) vf[PV_IDX(g)] = VFRAG(vp, PV_D(g) + 2, PV_KS(g));
            }
            pend = false;
        }
        vs_prev = t & 3;
        if (far) asm volatile("s_waitcnt vmcnt(3) lgkmcnt(0)" ::: "memory"); else asm volatile("s_waitcnt vmcnt(0) lgkmcnt(0)" ::: "memory");
        __builtin_amdgcn_s_barrier();
        asm volatile("" ::: "memory");
    }
    if (pend) {
        const LAS unsigned char* vp = lds + VOFF + vs_prev * VB + r32 * 128;
        bf16x8 vf[8];
#pragma unroll
        for (int g = 0; g < 8; ++g) vf[PV_IDX(g)] = VFRAG(vp, PV_D(g), PV_KS(g));
#pragma unroll
        for (int g = 0; g < NG; ++g) {
            o[PV_D(g)] = MFMA32(vf[PV_IDX(g)], pf[PV_KS(g)], o[PV_D(g)]);
            if (NDV == 4 && g < 8) vf[PV_IDX(g)] = VFRAG(vp, PV_D(g) + 2, PV_KS(g));
        }
    }
#undef PV_D
#undef PV_KS
#undef PV_IDX
#undef VFRAG
#undef ATT_DMA_K
#undef ATT_DMA_V
#undef ATT_KLOAD
    asm volatile("s_waitcnt lgkmcnt(0)" ::: "memory");
    __builtin_amdgcn_s_barrier();
    asm volatile("" ::: "memory");
    l_out = xhalf_sum(l);
}

__device__ __forceinline__ void attention_phase(const KP& p, LAS unsigned char* lds, unsigned char* ws, int rep) {
    int tid_l = threadIdx.x; asm volatile("" : "+v"(tid_l));
    const int tid0 = tid_l;
    const int xcd = blockIdx.x & 7;
    unsigned* const cbase = (unsigned*)(ws + WS_CTL) + (rep * 8) * 64;
    LAS unsigned* wq = (LAS unsigned*)(lds + LDS_STAGE);
    const float lam = __expf(wave_sum(p.lq1[tid0 & 63] * p.lk1[tid0 & 63])) - __expf(wave_sum(p.lq2[tid0 & 63] * p.lk2[tid0 & 63])) + p.lam_init;
    for (int qi = 0; qi < 8; ++qi) {
    const int qx = (xcd + qi) & 7;
    unsigned* counter = cbase + qx * 64;
    for (;;) {
        if (tid0 == 0) *wq = atomicAdd(counter, 1u);
        __syncthreads();
        const unsigned u = *wq;
        __syncthreads();
        if (u >= (unsigned)(NUNITS / 8)) break;
        int tid = tid_l; asm volatile("" : "+v"(tid));
        const int lane = tid & 63, r32 = lane & 31, hi = lane >> 5, wid = tid >> 6;
        const int code = ((const int*)(ws + WS_CTL + 32768))[u];
        const int qb = code >> 3, sidx = code & 7;
        const int w = sidx < 2 ? 2 * qx + sidx : 16 + 4 * qx + (sidx - 2);
        const int NT = 4 * (qb + 1), q0w = qb * 256 + wid * 32;
        if (w < 16) {
            const int b = w >> 2, h = w & 3; const size_t rb = (size_t)b * SEQ;
            const bf16_t* Qd = (const bf16_t*)(ws + WS_QD); const bf16_t* Kd = (const bf16_t*)(ws + WS_KD); const bf16_t* Vt = (const bf16_t*)(ws + WS_VTD) + ((size_t)(b * (SEQ / 64)) * 512 + h * 128) * 64;
            bf16_t* yo = ((bf16_t*)p.out) + (rb + q0w + r32) * 1024 + 512 + h * 128;
            {
                f32x16 oA[4]; float lA;
                attn_pass<64, 128, false>(lds, Qd + (rb + q0w + r32) * 512 + (2 * h) * 64, Kd + rb * 512 + (2 * h) * 64, 512, nullptr, Vt, NT, q0w, oA, lA, tid);
                const float ia = 1.0f / lA;
#pragma unroll
                for (int d = 0; d < 4; ++d)
#pragma unroll
                    for (int g = 0; g < 4; ++g) {
                        u32x2 wv; wv.x = cvtpk(oA[d][4 * g] * ia, oA[d][4 * g + 1] * ia); wv.y = cvtpk(oA[d][4 * g + 2] * ia, oA[d][4 * g + 3] * ia);
                        *(GAS u32x2*)(yo + 32 * d + 8 * g + 4 * hi) = wv;
                    }
            }
            f32x16 oB[4]; float lB;
            attn_pass<64, 128, false>(lds, Qd + (rb + q0w + r32) * 512 + (2 * h + 1) * 64, Kd + rb * 512 + (2 * h + 1) * 64, 512, nullptr, Vt, NT, q0w, oB, lB, tid);
            const float ib = lam / lB;
            float ss = 0.f;
#pragma unroll
            for (int d = 0; d < 4; ++d)
#pragma unroll
                for (int g = 0; g < 4; ++g) {
                    const u32x2 a = *(const GAS u32x2*)(yo + 32 * d + 8 * g + 4 * hi);
                    const float v0 = bf_lo(a.x) - oB[d][4 * g] * ib, v1 = bf_hi(a.x) - oB[d][4 * g + 1] * ib, v2 = bf_lo(a.y) - oB[d][4 * g + 2] * ib, v3 = bf_hi(a.y) - oB[d][4 * g + 3] * ib;
                    oB[d][4 * g] = v0; oB[d][4 * g + 1] = v1; oB[d][4 * g + 2] = v2; oB[d][4 * g + 3] = v3;
                    ss += (v0 * v0 + v1 * v1) + (v2 * v2 + v3 * v3);
                }
            ss = xhalf_sum(ss);
            const float rn = rsqrtf(ss * (1.0f / 128.0f) + EPS) * p.one_m_lam;
#pragma unroll
            for (int d = 0; d < 4; ++d)
#pragma unroll
                for (int g = 0; g < 4; ++g) {
                    const int dd = 32 * d + 8 * g + 4 * hi;
                    const f32x4 sg = *(const f32x4*)(p.subln + dd);
                    u32x2 wv; wv.x = cvtpk(oB[d][4 * g] * rn * sg[0], oB[d][4 * g + 1] * rn * sg[1]); wv.y = cvtpk(oB[d][4 * g + 2] * rn * sg[2], oB[d][4 * g + 3] * rn * sg[3]);
                    *(GAS u32x2*)(yo + dd) = wv;
                }
        } else {
            const int b = (w - 16) >> 3, h = (w - 16) & 7; const size_t rb = (size_t)b * SEQ;
            const bf16_t* Qm = (const bf16_t*)(ws + WS_QM); const bf16_t* Kn = (const bf16_t*)(ws + WS_KN); const bf16_t* Kr = (const bf16_t*)(ws + WS_KR) + rb * 32;
            const bf16_t* Vt = (const bf16_t*)(ws + WS_VTM) + ((size_t)(b * (SEQ / 64)) * 512 + h * 64) * 64;
            f32x16 oM[2]; float lM;
            attn_pass<96, 64, true>(lds, Qm + (rb + q0w + r32) * 768 + h * 96, Kn + rb * 512 + h * 64, 512, Kr, Vt, NT, q0w, oM, lM, tid);
            const float il = 1.0f / lM;
            bf16_t* yo = ((bf16_t*)p.out) + (rb + q0w + r32) * 1024 + h * 64;
#pragma unroll
            for (int d = 0; d < 2; ++d)
#pragma unroll
                for (int g = 0; g < 4; ++g) {
                    const int dd = 32 * d + 8 * g + 4 * hi;
                    u32x2 wv; wv.x = cvtpk(oM[d][4 * g] * il, oM[d][4 * g + 1] * il); wv.y = cvtpk(oM[d][4 * g + 2] * il, oM[d][4 * g + 3] * il);
                    *(u32x2*)(yo + dd) = wv;
                }
        }
    }
    }
}

__device__ __forceinline__ void final_phase(const KP& p, unsigned char* ws) {
    int tid_l = threadIdx.x; asm volatile("" : "+v"(tid_l));
    const int tid = tid_l, lane = tid & 63, wave = tid >> 6;
    const int gw = blockIdx.x * 8 + wave, NGW = gridDim.x * 8;
    const float* ssq = (const float*)(ws + WS_SSQD);
    f32x4 g[4];
#pragma unroll
    for (int j = 0; j < 4; ++j) g[j] = ((const f32x4*)p.nfin)[lane + 64 * j];
    const bf16_t* xb = (const bf16_t*)(ws + WS_XB);
    for (int m = gw; m < T; m += NGW) {
        const float rs = rsqrtf(Epi::rowsum(ssq, m, 16) * (1.0f / DM) + EPS);
        const u32x2* xr = (const u32x2*)(xb + (size_t)m * DM) + lane;
        f32x4* orow = (f32x4*)(p.out + (size_t)m * DM) + lane;
#pragma unroll
        for (int j = 0; j < 4; ++j) { const u32x2 w = xr[64 * j]; f32x4 v = (f32x4){bf_lo(w.x), bf_hi(w.x), bf_lo(w.y), bf_hi(w.y)}; v = v * rs * g[j]; orow[64 * j] = v; }
    }
}

#define XB_TMO      128
#define XB_XCNT(j)  (256  + 64 * (j))
#define XB_XSUB(j)  (1280 + 64 * (j))
#define XB_XGEN(j)  (2304 + 64 * (j))
#define XB_TOP      3328
#define XB_TOPGEN   3392
#define XCD_BAR_WORDS 3456
#define XB_SPIN_CAP (1u << 18)

__device__ __forceinline__ unsigned xb_ld(unsigned* p)              { return __hip_atomic_load(p, __ATOMIC_RELAXED, __HIP_MEMORY_SCOPE_AGENT); }
__device__ __forceinline__ unsigned xb_add(unsigned* p, unsigned v) { return __hip_atomic_fetch_add(p, v, __ATOMIC_RELAXED, __HIP_MEMORY_SCOPE_AGENT); }
__device__ __forceinline__ unsigned xb_xcc_id() { return (unsigned)__builtin_amdgcn_s_getreg((3 << 11) | 20) & 0xFu; }
#define XB_SPIN(cond, bar) do { unsigned _sp = 0; while (cond) { __builtin_amdgcn_s_sleep(1); \
    if ((++_sp & 255u) == 0u) { if (xb_ld(&(bar)[XB_TMO])) break; if (_sp > XB_SPIN_CAP) { atomicAdd(&(bar)[XB_TMO], 1u); break; } } } } while (0)

struct XcdBarrier {
    unsigned* bar; unsigned x;
    volatile LAS unsigned* st;
};

__device__ __forceinline__ XcdBarrier xcd_barrier_post(unsigned* bar, volatile LAS unsigned* st) {
    XcdBarrier b; b.bar = bar; b.x = xb_xcc_id(); b.st = st;
    if (threadIdx.x == 0) (void)xb_add(&bar[XB_XCNT(b.x)], 1u);
    return b;
}
__device__ __forceinline__ void xcd_barrier_complete(unsigned* bar, unsigned x, unsigned& nloc, unsigned& nx) {
    const unsigned G = gridDim.x * gridDim.y * gridDim.z;
    unsigned sum, cnt, mine, sp = 0u;
    for (;;) {
        sum = 0u; cnt = 0u; mine = 0u;
#pragma unroll
        for (unsigned j = 0; j < 16; ++j) { const unsigned c = xb_ld(&bar[XB_XCNT(j)]); sum += c; cnt += (c > 0u) ? 1u : 0u; mine = (j == x) ? c : mine; }
        if (sum == G) break;
        __builtin_amdgcn_s_sleep(1);
        if ((++sp & 255u) == 0u) { if (xb_ld(&bar[XB_TMO])) break; if (sp > XB_SPIN_CAP) { atomicAdd(&bar[XB_TMO], 1u); break; } }
    }
    nloc = mine > 0u ? mine : 1u; nx = cnt > 0u ? cnt : 1u;
}

__device__ __forceinline__ void xcd_barrier(const XcdBarrier& b) {
    asm volatile("s_waitcnt vmcnt(0)" ::: "memory");
    __syncthreads();
    if (threadIdx.x == 0) {
        unsigned* bar = b.bar;
        __builtin_amdgcn_s_waitcnt(0);
        unsigned nloc = b.st[0], nx = b.st[1];
        if (nloc == 0u) { xcd_barrier_complete(bar, b.x, nloc, nx); b.st[0] = nloc; b.st[1] = nx; }
        const unsigned old = xb_add(&bar[XB_XSUB(b.x)], 1u);
        const unsigned gen = old / nloc;
        if (old + 1u == (gen + 1u) * nloc) {
            __builtin_amdgcn_fence(__ATOMIC_RELEASE, "agent");
            asm volatile("s_waitcnt vmcnt(0)" ::: "memory");
            const unsigned og = xb_add(&bar[XB_TOP], 1u);
            const unsigned tg = og / nx;
            if (og + 1u == (tg + 1u) * nx) xb_add(&bar[XB_TOPGEN], 1u);
            else XB_SPIN(xb_ld(&bar[XB_TOPGEN]) == tg, bar);
            __builtin_amdgcn_fence(__ATOMIC_ACQUIRE, "agent");
            xb_add(&bar[XB_XGEN(b.x)], 1u);
            asm volatile("s_waitcnt vmcnt(0)" ::: "memory");
        } else {
            XB_SPIN(xb_ld(&bar[XB_XGEN(b.x)]) == gen, bar);
            __builtin_amdgcn_fence(__ATOMIC_ACQUIRE, "agent");
            asm volatile("s_waitcnt vmcnt(0)" ::: "memory");
        }
    }
    __syncthreads();
}

enum { ST_PRO = 0, ST_GEMM = 1, ST_ATT = 2, ST_FIN = 3 };
#ifndef REP_STEP
#define REP_STEP -1
#endif
#ifndef N_LAUNCH_SPLIT
#define N_LAUNCH_SPLIT 0
#endif

template <bool COOP>
__global__ void __launch_bounds__(512) fwd(KP p, int step_lo, int step_hi) {
    extern __shared__ __attribute__((aligned(16))) unsigned char lds_raw[];
    LAS unsigned char* lds = (LAS unsigned char*)lds_raw;
    volatile LAS unsigned* bst = (volatile LAS unsigned*)(lds + LDS_STAGE + 64);
    if (threadIdx.x < 2) bst[threadIdx.x] = 0u;
    __syncthreads();
    XcdBarrier gbar; gbar.bar = nullptr; gbar.x = 0; gbar.st = nullptr;
    if constexpr (COOP) gbar = xcd_barrier_post((unsigned*)(p.ws + WS_BAR), bst);
    if constexpr (COOP) { if (step_lo < 0) cg::this_grid().sync(); }
    for (int st = step_lo; st < step_hi; ++st) {
      const bool sync_after = !(st == 3 || st == 5 || st == 6 || st == 9 || st == 14);
      for (int rep = 0; rep < (st == REP_STEP ? 2 : 1); ++rep) {
        size_t wz = 0; asm volatile("" : "+s"(wz));
        unsigned char* ws = p.ws + wz;
        const int kind = st == 0 ? ST_PRO : st == 8 ? ST_ATT : st == 14 ? ST_FIN : ST_GEMM;
        const int job = st < 8 ? st - 1 : st - 2;
#ifndef NO_PRO
        if (kind == ST_PRO) prologue(p, lds, ws);
        else
#endif
#ifndef NO_ATT
        if (kind == ST_ATT) attention_phase(p, lds, ws, rep);
        else
#endif
        if (kind == ST_FIN) final_phase(p, ws);
        else {
            pg8::Gemm g; Epi E;
            E.mode = 0; E.np = 16; E.inv_dim = 1.0f / DM; E.f0 = 0.f; E.ssq = nullptr; E.i0 = nullptr; E.o0 = nullptr; E.o1 = nullptr; E.ssq_out = nullptr;
            E.ws = ws; E.scale = 1.f; E.mid_at = -1;
            const bf16_t* XB = (const bf16_t*)(ws + WS_XB); const bf16_t* HB = (const bf16_t*)(ws + WS_H);
            switch (job) {
            case 0:  g = {XB, (const bf16_t*)(ws + WS_W1GU), T, NGU, DM}; E.mode = M_SWIGLU; E.ssq = (const float*)(ws + WS_SSQA); E.o0 = ws + WS_H; break;
            case 1:  g = {HB, (const bf16_t*)(ws + WS_W1D), T, DM, FF}; E.mode = M_RESID; E.f0 = 0.5f; E.np = 0; E.i0 = ws + WS_XB; E.o0 = nullptr; E.o1 = ws + WS_XB; E.ssq_out = (float*)(ws + WS_SSQB); break;
            case 2:  g = {XB, (const bf16_t*)(ws + WS_WIN), T, NWIN, DM}; E.mode = M_WIN; E.ssq = (const float*)(ws + WS_SSQB); E.scale = p.scale_d; break;
            case 3:  g = {(const bf16_t*)(ws + WS_WDV), XB, 512, T, DM}; E.mode = M_VT; E.ssq = (const float*)(ws + WS_SSQB); E.o0 = ws + WS_VTD; break;
            case 4:  g = {(const bf16_t*)(ws + WS_CQ), (const bf16_t*)(ws + WS_WUQ), T, 768, 256}; E.mode = M_Q; E.ssq = (const float*)(ws + WS_SSQQ); E.np = 4; E.inv_dim = 1.0f / 256; E.o0 = ws + WS_QM; E.scale = p.scale_m; break;
            case 5:  g = {(const bf16_t*)(ws + WS_CKV), (const bf16_t*)(ws + WS_WUK), T, 512, 128}; E.mode = M_KN; E.ssq = (const float*)(ws + WS_SSQKV); E.np = 4; E.inv_dim = 1.0f / 128; E.o0 = ws + WS_KN; break;
            case 6:  g = {(const bf16_t*)(ws + WS_WUV), (const bf16_t*)(ws + WS_CKV), 512, T, 128}; E.mode = M_VT; E.ssq = (const float*)(ws + WS_SSQKV); E.np = 4; E.inv_dim = 1.0f / 128; E.o0 = ws + WS_VTM; break;
            case 7:  g = {(const bf16_t*)p.out, (const bf16_t*)(ws + WS_PM), T, DM, 1024}; E.mode = M_GATE1; E.i0 = ws + WS_GD; E.o0 = ws + WS_MG; E.mid_at = 8; break;
            case 8:  g = {(const bf16_t*)p.out, (const bf16_t*)(ws + WS_PM), 0, DM, 1024}; E.mode = M_GATE1; break;
            case 9:  g = {(const bf16_t*)(ws + WS_MG), (const bf16_t*)(ws + WS_WO), T, DM, DM}; E.mode = M_RESID; E.f0 = 1.0f; E.np = 0; E.i0 = ws + WS_XB; E.o0 = nullptr; E.o1 = ws + WS_XB; E.ssq_out = (float*)(ws + WS_SSQC); break;
            case 10: g = {XB, (const bf16_t*)(ws + WS_W2GU), T, NGU, DM}; E.mode = M_SWIGLU; E.ssq = (const float*)(ws + WS_SSQC); E.o0 = ws + WS_H; break;
            default: g = {HB, (const bf16_t*)(ws + WS_W2D), T, DM, FF}; E.mode = M_RESID; E.f0 = 0.5f; E.np = 0; E.i0 = ws + WS_XB; E.o0 = nullptr; E.o1 = ws + WS_XB; E.ssq_out = (float*)(ws + WS_SSQD); break;
            }
            pg8::StaticOrder S; S.init(g.M, g.N, (int)gridDim.x, (int)blockIdx.x);
#ifndef NO_GEMM
            pg8::gemm_phase<Epi, pg8::StaticOrder, true, true>(lds, g, S, E);
#endif
        }
      }
        if (sync_after && st + 1 < step_hi) {
            if constexpr (COOP) { xcd_barrier(gbar); }
        }
    }
}

extern "C" void kernel_launch(void* const* d_in, const int* in_sizes, int n_in, void* d_out, int out_size, void* d_ws, size_t ws_size, hipStream_t stream) {
    static int grid = 0;
    if (grid == 0) {
        if (n_in != 25 || ws_size < WS_END) { fprintf(stderr, "kernel_launch: unexpected n_in %d / ws_size %zu\n", n_in, ws_size); grid = -1; return; }
        int dev = 0, cus = 0, per_cu = 0;
        (void)hipGetDevice(&dev); (void)hipDeviceGetAttribute(&cus, hipDeviceAttributeMultiprocessorCount, dev);
        (void)hipFuncSetAttribute((const void*)fwd<N_LAUNCH_SPLIT == 0>, hipFuncAttributeMaxDynamicSharedMemorySize, LDS_BYTES);
        (void)hipOccupancyMaxActiveBlocksPerMultiprocessor(&per_cu, (const void*)fwd<N_LAUNCH_SPLIT == 0>, 512, LDS_BYTES);
        (void)hipGetLastError();
        if (per_cu < 1) per_cu = 1;
        grid = cus * 1;
        if (grid <= 0) grid = 256;
    }
    if (grid < 0) return;
    KP p{};
    p.x = (const float*)d_in[0]; p.pos = (const int*)d_in[1];
    p.n1 = (const float*)d_in[2]; p.wg1 = (const float*)d_in[3]; p.wu1 = (const float*)d_in[4]; p.wd1 = (const float*)d_in[5];
    p.nmix = (const float*)d_in[6]; p.win = (const float*)d_in[7]; p.nq = (const float*)d_in[8]; p.wuq = (const float*)d_in[9]; p.nkv = (const float*)d_in[10]; p.wukv = (const float*)d_in[11];
    p.lq1 = (const float*)d_in[12]; p.lk1 = (const float*)d_in[13]; p.lq2 = (const float*)d_in[14]; p.lk2 = (const float*)d_in[15]; p.subln = (const float*)d_in[16];
    p.pm = (const float*)d_in[17]; p.pd = (const float*)d_in[18]; p.wo = (const float*)d_in[19];
    p.n2 = (const float*)d_in[20]; p.wg2 = (const float*)d_in[21]; p.wu2 = (const float*)d_in[22]; p.wd2 = (const float*)d_in[23]; p.nfin = (const float*)d_in[24];
    p.out = (float*)d_out; p.ws = (unsigned char*)d_ws;
    for (int i = 0; i < 16; ++i) p.invf_m[i] = (float)pow(500000.0, -2.0 * i / 32.0);
    for (int i = 0; i < 8; ++i) p.invf_d[i] = (float)pow(500000.0, -2.0 * i / 16.0);
    p.scale_m = (float)(pow(96.0, -0.5) * 1.4426950408889634); p.scale_d = (float)(pow(64.0, -0.5) * 1.4426950408889634);
    const double lam_init = 0.8 - 0.6 * exp(-0.3 * 0.0);
    p.lam_init = (float)lam_init; p.one_m_lam = (float)(1.0 - lam_init);
#if N_LAUNCH_SPLIT
    const int cuts[] = {0, 1, 2, 3, 5, 8, 9, 11, 12, 13, 14, 15};
    for (int i = 0; i + 1 < (int)(sizeof(cuts) / sizeof(int)); ++i) {
        int lo = cuts[i], hi = cuts[i + 1];
        hipLaunchKernelGGL(fwd<false>, dim3(grid), dim3(512), LDS_BYTES, stream, p, lo, hi);
    }
#else
    if (hipMemsetAsync((char*)d_ws + WS_BAR, 0, BAR_BYTES, stream) != hipSuccess) { fprintf(stderr, "kernel_launch: memset of the barrier words failed\n"); return; }
    int lo = 0, hi = 15;
    void* args[] = {&p, &lo, &hi};
    hipError_t e = hipLaunchCooperativeKernel((const void*)fwd<true>, dim3(grid), dim3(512), args, LDS_BYTES, stream);
    if (e != hipSuccess) fprintf(stderr, "cooperative launch failed: %s (grid %d)\n", hipGetErrorString(e), grid);
#endif
}
```
